# Optimizing an MI355X kernel written in HIP

```python
import jax, jax.numpy as jnp
from jax import lax
import numpy as np

D_MODEL = 1024
BATCH = 32
SEQ = 256
DEPTH = 2
DEC_BATCH = 8
DEC_SEQ = 4096
PAST_LEN = 512

GRID_W = 64
MLA_HEADS = 8
NOPE_DIM = 64
ROPE_DIM = 32
ROPE_FREQS = ROPE_DIM // 4
V_DIM = 64
Q_LORA = 256
KV_LORA = 128
ROPE_BASE = 10000.0
Q_BLOCK = 128
SM_SCALE = (NOPE_DIM + ROPE_DIM) ** -0.5
POOL_WINDOWS = (2, 4, 8, 16)
POOL_GC = 64
POOL_W = POOL_GC * len(POOL_WINDOWS)
SGU_HEADS = 4
SGU_HD = 64
SGU_W = SGU_HEADS * SGU_HD
CHUNK = 128
IN_COLS = Q_LORA + KV_LORA + ROPE_DIM + POOL_W + 2 * SGU_W
MIX_W = MLA_HEADS * V_DIM + POOL_W + SGU_W
D_FF = 2816
CONV_W = 3
EPS = 1e-6

kernel_name = "hymba_mla_pool_sgu_diffusion_step"


def _rms(x, g):
    xf = x.astype(jnp.float32)
    y = xf * lax.rsqrt(jnp.mean(xf * xf, axis=-1, keepdims=True) + EPS)
    return (y * g.astype(jnp.float32)).astype(x.dtype)


def _axial_angles(S):
    n_rows = S // GRID_W
    rows = jnp.repeat(jnp.arange(n_rows, dtype=jnp.float32), GRID_W)
    cols = jnp.tile(jnp.arange(GRID_W, dtype=jnp.float32), n_rows)
    freqs = ROPE_BASE ** (-jnp.arange(ROPE_FREQS, dtype=jnp.float32) / ROPE_FREQS)
    ang = jnp.stack([rows[:, None] * freqs, cols[:, None] * freqs], axis=1)
    return jnp.cos(ang), jnp.sin(ang)


def _rope2d(x, cos, sin):
    xr = x.reshape(*x.shape[:-1], 2, 2, ROPE_FREQS)
    x1 = xr[..., 0, :].astype(jnp.float32)
    x2 = xr[..., 1, :].astype(jnp.float32)
    out = jnp.stack([x1 * cos - x2 * sin, x2 * cos + x1 * sin], axis=-2)
    return out.reshape(x.shape).astype(x.dtype)


def _block_attention(q_nope, q_rope, k_nope, k_rope, v):
    B, S, H, _ = q_nope.shape
    nb = S // Q_BLOCK
    qn = q_nope.reshape(B, nb, Q_BLOCK, H, NOPE_DIM).transpose(1, 0, 2, 3, 4)
    qr = q_rope.reshape(B, nb, Q_BLOCK, H, ROPE_DIM).transpose(1, 0, 2, 3, 4)

    def one(blk):
        qn_b, qr_b = blk
        s = (jnp.einsum('bqhd,bkhd->bhqk', qn_b, k_nope)
             + jnp.einsum('bqhr,bkr->bhqk', qr_b, k_rope)).astype(jnp.float32) * SM_SCALE
        p = jax.nn.softmax(s, axis=-1).astype(v.dtype)
        return jnp.einsum('bhqk,bkhd->bqhd', p, v)

    o = lax.map(one, (qn, qr))
    return o.transpose(1, 0, 2, 3, 4).reshape(B, S, H * V_DIM)


def _multiscale_pool(x, w_pool, pool_scale):
    B, S, _ = x.shape
    xf = x.astype(jnp.float32)
    cs = jnp.concatenate([jnp.zeros((B, 1, POOL_W), jnp.float32), jnp.cumsum(xf, axis=1)], axis=1)
    t = jnp.arange(S)
    outs = []
    for g, w in enumerate(POOL_WINDOWS):
        lo = jnp.clip(t - w // 2, 0, S)
        hi = jnp.clip(t + w - w // 2, 0, S)
        seg = cs[:, :, g * POOL_GC:(g + 1) * POOL_GC]
        tot = jnp.take(seg, hi, axis=1) - jnp.take(seg, lo, axis=1)
        mean = tot / (hi - lo).astype(jnp.float32)[None, :, None]
        outs.append(mean - xf[:, :, g * POOL_GC:(g + 1) * POOL_GC])
    d = jnp.stack(outs, axis=2).astype(x.dtype)
    y = jnp.einsum('bsgc,gce->bsge', d, w_pool).reshape(B, S, POOL_W)
    return y * pool_scale


def _spatial_gate(x, g_sgu, w_sgu, b_sgu):
    u, v = x[..., :SGU_W], x[..., SGU_W:]
    v = _rms(v, g_sgu)
    B, S, _ = v.shape
    nc = S // CHUNK
    v = v.reshape(B, nc, CHUNK, SGU_HEADS, SGU_HD)
    z = jnp.einsum('hqp,bnphd->bnqhd', w_sgu, v) + b_sgu.T[None, None, :, :, None]
    return u * z.reshape(B, S, SGU_W)


def _mixer(h, p, latent, ctx_ckv, ctx_krope):
    B, S, _ = h.shape
    proj = jnp.einsum('bsd,de->bse', h, p['w_in'])
    o1 = Q_LORA
    o2 = o1 + KV_LORA
    o3 = o2 + ROPE_DIM
    o4 = o3 + POOL_W
    qa, kva, kr, pool_in, sgu_in = proj[..., :o1], proj[..., o1:o2], proj[..., o2:o3], proj[..., o3:o4], proj[..., o4:]
    q = jnp.einsum('bsr,re->bse', _rms(qa, p['g_q_a']), p['w_q_b']).reshape(B, S, MLA_HEADS, NOPE_DIM + ROPE_DIM)
    q_nope, q_rope = q[..., :NOPE_DIM], q[..., NOPE_DIM:]
    ckv = _rms(kva, p['g_kv_a'])
    if latent:
        cos, sin = _axial_angles(S)
        q_rope = _rope2d(q_rope, cos[:, None], sin[:, None])
        kr_lat = _rope2d(kr, cos, sin)
        ckv_all = jnp.concatenate([ctx_ckv, ckv], axis=1)
        kr_all = jnp.concatenate([ctx_krope, kr_lat], axis=1)
    else:
        ckv_all, kr_all = ckv, kr
    T = ckv_all.shape[1]
    kv = jnp.einsum('btr,re->bte', ckv_all, p['w_kv_b']).reshape(B, T, MLA_HEADS, NOPE_DIM + V_DIM)
    k_nope, v = kv[..., :NOPE_DIM], kv[..., NOPE_DIM:]
    attn = _block_attention(q_nope, q_rope, k_nope, kr_all, v)
    pool = _multiscale_pool(pool_in, p['w_pool'], p['pool_scale'])
    sgu = _spatial_gate(sgu_in, p['g_sgu'], p['w_sgu'], p['b_sgu'])
    out = jnp.einsum('bse,ed->bsd', jnp.concatenate([attn, pool, sgu], axis=-1), p['w_out'])
    return out, ckv, kr


def _conv_ffn(h, w_up, conv_w, conv_b, w_down):
    z = jnp.einsum('bsd,df->bsf', h, w_up)
    zp = jnp.pad(z, ((0, 0), (1, 1), (0, 0)))
    z = zp[:, :-2] * conv_w[0] + zp[:, 1:-1] * conv_w[1] + zp[:, 2:] * conv_w[2] + conv_b
    g, val = z[..., :D_FF], z[..., D_FF:]
    return jnp.einsum('bsf,fd->bsd', jax.nn.silu(g) * val, w_down)


def _layer(x, mod, p, latent, ctx_ckv, ctx_krope):
    shift_m, scale_m, gate_m, shift_f, scale_f, gate_f = jnp.split(mod, 6, axis=-1)
    h = _rms(x, p['g_pre_mix']) * (1 + scale_m) + shift_m
    out, ckv, kr = _mixer(h, p, latent, ctx_ckv, ctx_krope)
    x = x + gate_m * _rms(out, p['g_post_mix'])
    h = _rms(x, p['g_pre_ffn']) * (1 + scale_f) + shift_f
    x = x + gate_f * _rms(_conv_ffn(h, p['w_up'], p['conv_w'], p['conv_b'], p['w_down']), p['g_post_ffn'])
    return x, ckv, kr


def setup_inputs(seed: int = 0) -> dict:
    key = jax.random.key(seed)
    ks = jax.random.split(key, 32)
    nrm = lambda k, shp, s: jax.random.normal(k, shp, jnp.float32) * s
    gain = lambda k, n: 1.0 + nrm(k, (DEPTH, n), 0.02)
    return {
        "x_prompt": nrm(ks[0], (BATCH, SEQ, D_MODEL), 1.0),
        "x_sample": nrm(ks[1], (DEC_BATCH, DEC_SEQ, D_MODEL), 1.0),
        "cache_ckv": nrm(ks[2], (DEC_BATCH, DEPTH, PAST_LEN, KV_LORA), 1.0),
        "cache_krope": nrm(ks[3], (DEC_BATCH, DEPTH, PAST_LEN, ROPE_DIM), 1.0),
        "c": nrm(ks[4], (DEC_BATCH, D_MODEL), 1.0),
        "c_ctx": nrm(ks[5], (D_MODEL,), 1.0),
        "w_mod": nrm(ks[6], (DEPTH, D_MODEL, 6 * D_MODEL), D_MODEL ** -0.5),
        "b_mod": nrm(ks[7], (DEPTH, 6 * D_MODEL), 0.02),
        "g_pre_mix": gain(ks[8], D_MODEL),
        "g_post_mix": gain(ks[9], D_MODEL),
        "g_pre_ffn": gain(ks[10], D_MODEL),
        "g_post_ffn": gain(ks[11], D_MODEL),
        "w_in": nrm(ks[12], (DEPTH, D_MODEL, IN_COLS), D_MODEL ** -0.5),
        "g_q_a": gain(ks[13], Q_LORA),
        "w_q_b": nrm(ks[14], (DEPTH, Q_LORA, MLA_HEADS * (NOPE_DIM + ROPE_DIM)), Q_LORA ** -0.5),
        "g_kv_a": gain(ks[15], KV_LORA),
        "w_kv_b": nrm(ks[16], (DEPTH, KV_LORA, MLA_HEADS * (NOPE_DIM + V_DIM)), KV_LORA ** -0.5),
        "w_pool": nrm(ks[17], (DEPTH, len(POOL_WINDOWS), POOL_GC, POOL_GC), POOL_GC ** -0.5),
        "pool_scale": 1.0 + nrm(ks[18], (DEPTH, POOL_W), 0.1),
        "g_sgu": gain(ks[19], SGU_W),
        "w_sgu": nrm(ks[20], (DEPTH, SGU_HEADS, CHUNK, CHUNK), CHUNK ** -0.5),
        "b_sgu": 1.0 + nrm(ks[21], (DEPTH, SGU_HEADS, CHUNK), 0.02),
        "w_out": nrm(ks[22], (DEPTH, MIX_W, D_MODEL), MIX_W ** -0.5),
        "w_up": nrm(ks[23], (DEPTH, D_MODEL, 2 * D_FF), D_MODEL ** -0.5),
        "conv_w": nrm(ks[24], (DEPTH, CONV_W, 2 * D_FF), CONV_W ** -0.5),
        "conv_b": nrm(ks[25], (DEPTH, 2 * D_FF), 0.02),
        "w_down": nrm(ks[26], (DEPTH, D_FF, D_MODEL), D_FF ** -0.5),
    }


def reference(x_prompt, x_sample, cache_ckv, cache_krope, c, c_ctx, w_mod, b_mod,
              g_pre_mix, g_post_mix, g_pre_ffn, g_post_ffn, w_in, g_q_a, w_q_b, g_kv_a, w_kv_b,
              w_pool, pool_scale, g_sgu, w_sgu, b_sgu, w_out, w_up, conv_w, conv_b, w_down):
    xp, xs = x_prompt, x_sample
    ckv_list, kr_list = [], []
    for l in range(DEPTH):
        p = {
            'g_pre_mix': g_pre_mix[l], 'g_post_mix': g_post_mix[l],
            'g_pre_ffn': g_pre_ffn[l], 'g_post_ffn': g_post_ffn[l],
            'w_in': w_in[l], 'g_q_a': g_q_a[l], 'w_q_b': w_q_b[l],
            'g_kv_a': g_kv_a[l], 'w_kv_b': w_kv_b[l],
            'w_pool': w_pool[l], 'pool_scale': pool_scale[l],
            'g_sgu': g_sgu[l], 'w_sgu': w_sgu[l], 'b_sgu': b_sgu[l],
            'w_out': w_out[l], 'w_up': w_up[l], 'conv_w': conv_w[l],
            'conv_b': conv_b[l], 'w_down': w_down[l],
        }
        mod_ctx = (jnp.einsum('d,de->e', jax.nn.silu(c_ctx), w_mod[l]) + b_mod[l])[None, None, :]
        mod_lat = (jnp.einsum('bd,de->be', jax.nn.silu(c), w_mod[l]) + b_mod[l])[:, None, :]
        xp, ckv, kr = _layer(xp, mod_ctx, p, False, None, None)
        ckv_list.append(ckv)
        kr_list.append(kr)
        xs, _, _ = _layer(xs, mod_lat, p, True, cache_ckv[:, l], cache_krope[:, l])
    new_ckv = jnp.stack(ckv_list, axis=1)
    new_krope = jnp.stack(kr_list, axis=1)
    return (xp, xs, new_ckv, new_krope)
```

```cpp
#include <hip/hip_runtime.h>
#include <hip/hip_cooperative_groups.h>
#include <cstdio>
#include <cstdint>
namespace cg = cooperative_groups;

typedef unsigned short u16;
using bf16x8 = __attribute__((ext_vector_type(8))) short;
using s16x4  = __attribute__((ext_vector_type(4))) short;
using f32x16 = __attribute__((ext_vector_type(16))) float;
using u32x4  = __attribute__((ext_vector_type(4))) unsigned;
using u32x2  = __attribute__((ext_vector_type(2))) unsigned;

constexpr int DM = 1024, DEPTH = 2;
constexpr int M_CTX = 8192, M_LAT = 32768, M_TOK = 40960;
constexpr int S_CTX = 256, S_LAT = 4096, PAST = 512, T_LAT = 4608;
constexpr int KV_ROWS = M_CTX + 8 * T_LAT;
constexpr int IN_COLS = 1184, IN_PAD = 1280;
constexpr int DFF = 2816;
constexpr float EPS = 1e-6f;
constexpr int NTHR = 512;

constexpr size_t WL_IN = 0;
constexpr size_t WL_QB = WL_IN + (size_t)IN_PAD * 1024 * 2;
constexpr size_t WL_KVB = WL_QB + (size_t)768 * 256 * 2;
constexpr size_t WL_POOL = WL_KVB + (size_t)1024 * 128 * 2;
constexpr size_t WL_SGU = WL_POOL + (size_t)256 * 256 * 2;
constexpr size_t WL_OUT = WL_SGU + (size_t)4 * 128 * 128 * 2;
constexpr size_t WL_UP = WL_OUT + (size_t)1024 * 1024 * 2;
constexpr size_t WL_DOWN = WL_UP + (size_t)5632 * 1024 * 2;
constexpr size_t WL_SIZE = WL_DOWN + (size_t)1024 * 2816 * 2;
constexpr size_t OFF_W = 0;
constexpr size_t OFF_MOD = OFF_W + 2 * WL_SIZE;
constexpr size_t OFF_TAB = OFF_MOD + (size_t)2 * 9 * 6144 * 4;
constexpr size_t OFF_BAR = OFF_TAB + 4096;
constexpr size_t OFF_C = OFF_BAR + 16384;
constexpr size_t OFF_A = OFF_C + (size_t)M_TOK * 1024 * 2;
constexpr size_t A_PROJ = OFF_A;
constexpr size_t A_QAN = A_PROJ + (size_t)M_TOK * IN_COLS * 2;
constexpr size_t A_CKV = A_QAN + (size_t)M_TOK * 256 * 2;
constexpr size_t A_DPOOL = A_CKV + (size_t)KV_ROWS * 128 * 2;
constexpr size_t A_VT = A_DPOOL + (size_t)M_TOK * 256 * 2;
constexpr size_t A_END = A_VT + (size_t)M_TOK * 256 * 2;
constexpr size_t OFF_B = OFF_A + (size_t)M_TOK * DFF * 2;
static_assert(A_END <= OFF_B, "region A overflow");
constexpr size_t B_Q = OFF_B;
constexpr size_t B_KV = B_Q + (size_t)M_TOK * 768 * 2;
constexpr size_t B_KR = B_KV + (size_t)KV_ROWS * 1024 * 2;
constexpr size_t B_END = B_KR + (size_t)KV_ROWS * 32 * 2;
constexpr size_t WS_END = OFF_B + (size_t)M_TOK * 1024 * 4;
static_assert(B_END <= WS_END, "region B overflow");

constexpr size_t OUT_CKV = (size_t)M_TOK * 1024;
constexpr size_t OUT_KR = OUT_CKV + (size_t)32 * 2 * 256 * 128;

constexpr int LDS_MAIN = 135168;
constexpr int LDS_BYTES = LDS_MAIN + 16;

struct Params {
  const float *x_prompt, *x_sample, *cache_ckv, *cache_krope, *c, *c_ctx, *w_mod, *b_mod,
      *g_pre_mix, *g_post_mix, *g_pre_ffn, *g_post_ffn, *w_in, *g_q_a, *w_q_b, *g_kv_a, *w_kv_b,
      *w_pool, *pool_scale, *g_sgu, *w_sgu, *b_sgu, *w_out, *w_up, *conv_w, *conv_b, *w_down;
  float* out;
  char* ws;
};

typedef float f32x2_t __attribute__((ext_vector_type(2)));
typedef __bf16 bf16x2_t __attribute__((ext_vector_type(2)));
__device__ __forceinline__ unsigned cvtpk(float lo, float hi) {
  f32x2_t v = {lo, hi};
  bf16x2_t r = __builtin_convertvector(v, bf16x2_t);
  return __builtin_bit_cast(unsigned, r);
}
__device__ __forceinline__ u16 f2bf(float x) { return (u16)(cvtpk(x, 0.f) & 0xffffu); }
__device__ __forceinline__ float bf2f(u16 b) { return __uint_as_float(((unsigned)b) << 16); }
__device__ __forceinline__ float bflo(unsigned w) { return __uint_as_float(w << 16); }
__device__ __forceinline__ float bfhi(unsigned w) { return __uint_as_float(w & 0xffff0000u); }
__device__ __forceinline__ float wave_sum(float v) {
  v += __int_as_float(__builtin_amdgcn_mov_dpp(__float_as_int(v), 0xB1, 0xF, 0xF, true));
  v += __int_as_float(__builtin_amdgcn_mov_dpp(__float_as_int(v), 0x4E, 0xF, 0xF, true));
  v += __int_as_float(__builtin_amdgcn_mov_dpp(__float_as_int(v), 0x124, 0xF, 0xF, true));
  v += __int_as_float(__builtin_amdgcn_mov_dpp(__float_as_int(v), 0x128, 0xF, 0xF, true));
  v += __shfl_xor(v, 16);
  v += __shfl_xor(v, 32);
  return v;
}
__device__ __forceinline__ int opaque_tid() { int t = threadIdx.x; asm volatile("" : "+v"(t)); return t; }
__device__ __forceinline__ int crow(int r, int hi) { return (r & 3) + 8 * (r >> 2) + 4 * hi; }
__device__ __forceinline__ float silu_f(float x) { return x * __builtin_amdgcn_rcpf(1.f + __builtin_amdgcn_exp2f(-1.4426950408889634f * x)); }

#define KARG __attribute__((address_space(4)))
#define PHASE_PARAMS const KARG char* kp_ = (const KARG char*)__builtin_amdgcn_kernarg_segment_ptr(); asm volatile("" : "+s"(kp_)); Params p; \
  p.x_prompt = *(const float* const KARG*)(kp_ + 0); \
  p.x_sample = *(const float* const KARG*)(kp_ + 8); \
  p.cache_ckv = *(const float* const KARG*)(kp_ + 16); \
  p.cache_krope = *(const float* const KARG*)(kp_ + 24); \
  p.c = *(const float* const KARG*)(kp_ + 32); \
  p.c_ctx = *(const float* const KARG*)(kp_ + 40); \
  p.w_mod = *(const float* const KARG*)(kp_ + 48); \
  p.b_mod = *(const float* const KARG*)(kp_ + 56); \
  p.g_pre_mix = *(const float* const KARG*)(kp_ + 64); \
  p.g_post_mix = *(const float* const KARG*)(kp_ + 72); \
  p.g_pre_ffn = *(const float* const KARG*)(kp_ + 80); \
  p.g_post_ffn = *(const float* const KARG*)(kp_ + 88); \
  p.w_in = *(const float* const KARG*)(kp_ + 96); \
  p.g_q_a = *(const float* const KARG*)(kp_ + 104); \
  p.w_q_b = *(const float* const KARG*)(kp_ + 112); \
  p.g_kv_a = *(const float* const KARG*)(kp_ + 120); \
  p.w_kv_b = *(const float* const KARG*)(kp_ + 128); \
  p.w_pool = *(const float* const KARG*)(kp_ + 136); \
  p.pool_scale = *(const float* const KARG*)(kp_ + 144); \
  p.g_sgu = *(const float* const KARG*)(kp_ + 152); \
  p.w_sgu = *(const float* const KARG*)(kp_ + 160); \
  p.b_sgu = *(const float* const KARG*)(kp_ + 168); \
  p.w_out = *(const float* const KARG*)(kp_ + 176); \
  p.w_up = *(const float* const KARG*)(kp_ + 184); \
  p.conv_w = *(const float* const KARG*)(kp_ + 192); \
  p.conv_b = *(const float* const KARG*)(kp_ + 200); \
  p.w_down = *(const float* const KARG*)(kp_ + 208); \
  p.out = *(float* const KARG*)(kp_ + 216); p.ws = *(char* const KARG*)(kp_ + 224)
__device__ __forceinline__ void cvt_tile_T(const float* __restrict__ src, int ld_src, u16* __restrict__ dst, int K, int kt, int nt, int mode,
                           int Nvalid, float* t) {
  const int tid = opaque_tid();
  const int k0 = kt * 64, n0 = nt * 128;
  {
    const int n = n0 + (tid & 127);
    int sc; bool valid;
    if (mode == 1) { const int t256 = n >> 8, wn = (n >> 6) & 3, blk = (n >> 5) & 1, c = n & 31; sc = blk * DFF + t256 * 128 + wn * 32 + c; valid = true; }
    else { sc = n; valid = n < Nvalid; }
    float v[16];
#pragma unroll
    for (int i = 0; i < 16; ++i) { const int k = (tid >> 7) + 4 * i; v[i] = valid ? src[(long)(k0 + k) * ld_src + sc] : 0.f; }
#pragma unroll
    for (int i = 0; i < 16; ++i) { const int k = (tid >> 7) + 4 * i; t[k * 129 + (tid & 127)] = v[i]; }
  }
  __syncthreads();
  {
    const int n = tid >> 2, kc = tid & 3;
    float v[16];
#pragma unroll
    for (int j = 0; j < 16; ++j) v[j] = t[(kc * 16 + j) * 129 + n];
    u32x4 w0 = {cvtpk(v[0], v[1]), cvtpk(v[2], v[3]), cvtpk(v[4], v[5]), cvtpk(v[6], v[7])};
    u32x4 w1 = {cvtpk(v[8], v[9]), cvtpk(v[10], v[11]), cvtpk(v[12], v[13]), cvtpk(v[14], v[15])};
    u16* d = dst + (long)(n0 + n) * K + k0 + kc * 16;
    *(u32x4*)d = w0; *(u32x4*)(d + 8) = w1;
  }
  __syncthreads();
}

__device__ __forceinline__ void mod_job(const Params& p, int l, int nt64, float* lds) {
  char* wsb = p.ws; asm volatile("" : "+s"(wsb));
  const int tid = opaque_tid();
  float* sc = lds; float* red = lds + 9216;
  for (int idx = tid; idx < 9216; idx += NTHR) {
    const int r = idx >> 10, k = idx & 1023;
    const float x = (r == 0) ? p.c_ctx[k] : p.c[(r - 1) * 1024 + k];
    sc[idx] = x / (1.f + expf(-x));
  }
  __syncthreads();
  const int kq = tid >> 6, cc = tid & 63, n = nt64 * 64 + cc;
  float acc[9];
#pragma unroll
  for (int r = 0; r < 9; ++r) acc[r] = 0.f;
  const float* wp = p.w_mod + ((long)l * 1024 + kq * 128) * 6144 + n;
#pragma unroll 32
  for (int kk = 0; kk < 128; ++kk) {
    const float w = wp[(long)kk * 6144];
    const int k = kq * 128 + kk;
#pragma unroll
    for (int r = 0; r < 9; ++r) acc[r] = fmaf(sc[r * 1024 + k], w, acc[r]);
  }
#pragma unroll
  for (int r = 0; r < 9; ++r) red[(kq * 9 + r) * 64 + cc] = acc[r];
  __syncthreads();
  float* mod = (float*)(wsb + OFF_MOD);
  for (int idx = tid; idx < 576; idx += NTHR) {
    const int r = idx >> 6, c2 = idx & 63, n2 = nt64 * 64 + c2;
    float s = p.b_mod[l * 6144 + n2];
#pragma unroll
    for (int q = 0; q < 8; ++q) s += red[(q * 9 + r) * 64 + c2];
    mod[(l * 9 + r) * 6144 + n2] = s;
  }
  __syncthreads();
}

__device__ __forceinline__ void phase_prep(const Params& p_unused_, char* lds) {
  PHASE_PARAMS;
  char* wsb = p.ws; asm volatile("" : "+s"(wsb));
  const int tid = opaque_tid();
  constexpr int PER_L = 1416;
  constexpr int NJOBS = 193 + 2 * PER_L;
  for (int job = blockIdx.x; job < NJOBS; job += gridDim.x) {
    if (job < 192) { mod_job(p, job / 96, job % 96, (float*)lds); continue; }
    if (job == 192) {
      float2* tab = (float2*)(wsb + OFF_TAB);
      const int pos = tid >> 3, f = tid & 7;
      const float freq = powf(10000.f, -(float)f / 8.f);
      const float ang = (float)pos * freq;
      tab[tid] = make_float2(cosf(ang), sinf(ang));
      continue;
    }
    int j = job - 193; const int l = j / PER_L; j -= l * PER_L;
    char* wl = wsb + OFF_W + (size_t)l * WL_SIZE;
    float* t = (float*)lds;
    if (j < 160) { cvt_tile_T(p.w_in + (size_t)l * 1024 * IN_COLS, IN_COLS, (u16*)(wl + WL_IN), 1024, j / 10, j % 10, 0, IN_COLS, t); continue; }
    j -= 160;
    if (j < 24) { cvt_tile_T(p.w_q_b + (size_t)l * 256 * 768, 768, (u16*)(wl + WL_QB), 256, j / 6, j % 6, 0, 768, t); continue; }
    j -= 24;
    if (j < 16) { cvt_tile_T(p.w_kv_b + (size_t)l * 128 * 1024, 1024, (u16*)(wl + WL_KVB), 128, j / 8, j % 8, 0, 1024, t); continue; }
    j -= 16;
    if (j < 128) { cvt_tile_T(p.w_out + (size_t)l * 1024 * 1024, 1024, (u16*)(wl + WL_OUT), 1024, j / 8, j % 8, 0, 1024, t); continue; }
    j -= 128;
    if (j < 704) { cvt_tile_T(p.w_up + (size_t)l * 1024 * 5632, 5632, (u16*)(wl + WL_UP), 1024, j / 44, j % 44, 1, 5632, t); continue; }
    j -= 704;
    if (j < 352) { cvt_tile_T(p.w_down + (size_t)l * 2816 * 1024, 1024, (u16*)(wl + WL_DOWN), 2816, j / 8, j % 8, 0, 1024, t); continue; }
    j -= 352;
    if (j < 16) {
      u16* dst = (u16*)(wl + WL_POOL);
      for (int i = 0; i < 8; ++i) {
        const int idx = j * 4096 + i * 512 + tid; const int n = idx >> 8, k = idx & 255;
        const int g = n >> 6, e = n & 63, g2 = k >> 6, c = k & 63;
        dst[idx] = (g == g2) ? f2bf(p.w_pool[(((size_t)l * 4 + g) * 64 + c) * 64 + e]) : (u16)0;
      }
      continue;
    }
    j -= 16;
    {
      u16* dst = (u16*)(wl + WL_SGU);
      for (int i = 0; i < 8; ++i) { const int idx = j * 4096 + i * 512 + tid; dst[idx] = f2bf(p.w_sgu[(size_t)l * 65536 + idx]); }
    }
  }
}

__device__ __forceinline__ void phase_rows(const Params& p_unused_, int mode, int l) {
  PHASE_PARAMS;
  char* wsb = p.ws; asm volatile("" : "+s"(wsb));
  const int tid = opaque_tid(), wid = tid >> 6, lane = tid & 63;
  const float* mod = (const float*)(wsb + OFF_MOD);
  const u16* obuf = (const u16*)(wsb + OFF_B);
  u16* hbuf = (u16*)(wsb + OFF_C);
  u16* x1buf = (u16*)(wsb + OFF_B + (size_t)M_TOK * 1024 * 2);
  u16* x2buf = (u16*)p.out;
  const bool from_in = (mode == 0 || (mode == 1 && l == 0));
  const bool final_out = (mode == 2 && l + 1 >= DEPTH);
  const u16* xsrc = (mode == 1) ? x2buf : x1buf;
  u16* xdst = (mode == 1) ? x1buf : x2buf;
  const int stride = gridDim.x * 8;
  float4 xn[2][4]; u32x2 xbn[2][4]; u32x2 on[2][4];
#define ROW_LOAD(k, mm) do { const int m_ = (mm); \
    if (from_in) { const float* xs_ = (m_ < M_CTX) ? p.x_prompt + (size_t)m_ * 1024 : p.x_sample + (size_t)(m_ - M_CTX) * 1024; \
      _Pragma("unroll") for (int i = 0; i < 4; ++i) xn[k][i] = *(const float4*)(xs_ + i * 256 + lane * 4); } \
    else { _Pragma("unroll") for (int i = 0; i < 4; ++i) xbn[k][i] = *(const u32x2*)(xsrc + (size_t)m_ * 1024 + i * 256 + lane * 4); } \
    if (mode != 0) { _Pragma("unroll") for (int i = 0; i < 4; ++i) on[k][i] = *(const u32x2*)(obuf + (size_t)m_ * 1024 + i * 256 + lane * 4); } } while (0)
  const int per = (((M_TOK + stride - 1) / stride) + 1) & ~1;
  int m = (blockIdx.x * 8 + wid) * per;
  const int mend = min(m + per, M_TOK);
  if (m < mend) { ROW_LOAD(0, m); ROW_LOAD(1, m + 1); }
  const int step = 2;
  const int nk = 2;
  const int lh_ = (mode == 2) ? l + 1 : l;
  float4 c_gp[4], c_gpre[4], c_gate[4], c_shift[4], c_scale[4];
  {
    const float* gp_ = ((mode == 1) ? p.g_post_mix : p.g_post_ffn) + l * 1024;
    const float* gpre_ = ((mode == 1) ? p.g_pre_ffn : p.g_pre_mix) + (final_out ? l : lh_) * 1024;
#pragma unroll
    for (int i = 0; i < 4; ++i) { c_gp[i] = *(const float4*)(gp_ + i * 256 + lane * 4); c_gpre[i] = *(const float4*)(gpre_ + i * 256 + lane * 4); }
  }
  int rcur = -1;
  for (; m < mend; m += step) {
    {
      const int rnew = (m < M_CTX) ? 0 : 1 + ((m - M_CTX) >> 12);
      if (rnew != rcur) {
        rcur = rnew;
        const float* gate_ = mod + ((size_t)l * 9 + rnew) * 6144 + ((mode == 1) ? 2 : 5) * 1024;
        const float* modh_ = mod + ((size_t)(final_out ? l : lh_) * 9 + rnew) * 6144;
        const float* shift_ = modh_ + ((mode == 1) ? 3 : 0) * 1024;
        const float* scale_ = modh_ + ((mode == 1) ? 4 : 1) * 1024;
#pragma unroll
        for (int i = 0; i < 4; ++i) {
          c_gate[i] = *(const float4*)(gate_ + i * 256 + lane * 4);
          c_shift[i] = *(const float4*)(shift_ + i * 256 + lane * 4);
          c_scale[i] = *(const float4*)(scale_ + i * 256 + lane * 4);
        }
      }
    }
    float4 x[2][4]; u32x2 ow[2][4];
#pragma unroll
    for (int k = 0; k < 2; ++k)
#pragma unroll
      for (int i = 0; i < 4; ++i) {
        x[k][i] = from_in ? xn[k][i] : make_float4(bflo(xbn[k][i][0]), bfhi(xbn[k][i][0]), bflo(xbn[k][i][1]), bfhi(xbn[k][i][1]));
        ow[k][i] = on[k][i];
      }
    if (m + step < mend) { ROW_LOAD(0, m + step); ROW_LOAD(1, m + step + 1); }
    float rstd_o[2], rstd_x[2];
    int rr[2];
#pragma unroll
    for (int k = 0; k < 2; ++k) { const int mk = m + k; rr[k] = (mk < M_CTX) ? 0 : 1 + ((mk - M_CTX) >> 12); }
    if (mode != 0) {
      float ss[2];
#pragma unroll
      for (int k = 0; k < 2; ++k) {
        ss[k] = 0.f;
#pragma unroll
        for (int i = 0; i < 4; ++i) { const float a = bflo(ow[k][i][0]), b = bfhi(ow[k][i][0]), c = bflo(ow[k][i][1]), d = bfhi(ow[k][i][1]); ss[k] += a * a + b * b + c * c + d * d; }
      }
      ss[0] = wave_sum(ss[0]); ss[1] = wave_sum(ss[1]);
      rstd_o[0] = rsqrtf(ss[0] * (1.f / 1024.f) + EPS); rstd_o[1] = rsqrtf(ss[1] * (1.f / 1024.f) + EPS);
      const float* gp = ((mode == 1) ? p.g_post_mix : p.g_post_ffn) + l * 1024;
#pragma unroll
      for (int k = 0; k < 2; ++k) {
        if (k >= nk) break;
        const int mk = m + k;
        const float* gate = mod + ((size_t)l * 9 + rr[k]) * 6144 + ((mode == 1) ? 2 : 5) * 1024;
#pragma unroll
        for (int i = 0; i < 4; ++i) {
          const int c = i * 256 + lane * 4;
          const float4 g = c_gp[i], gt = c_gate[i];
          x[k][i].x += gt.x * (bflo(ow[k][i][0]) * rstd_o[k] * g.x); x[k][i].y += gt.y * (bfhi(ow[k][i][0]) * rstd_o[k] * g.y);
          x[k][i].z += gt.z * (bflo(ow[k][i][1]) * rstd_o[k] * g.z); x[k][i].w += gt.w * (bfhi(ow[k][i][1]) * rstd_o[k] * g.w);
          if (final_out) *(float4*)(p.out + (size_t)mk * 1024 + c) = x[k][i];
          else { u32x2 w = {cvtpk(x[k][i].x, x[k][i].y), cvtpk(x[k][i].z, x[k][i].w)}; *(u32x2*)(xdst + (size_t)mk * 1024 + c) = w; }
        }
      }
    }
    if (final_out) continue;
    const int lh = (mode == 2) ? l + 1 : l;
    const float* gpre = ((mode == 1) ? p.g_pre_ffn : p.g_pre_mix) + lh * 1024;
    {
      float ss[2];
#pragma unroll
      for (int k = 0; k < 2; ++k) {
        ss[k] = 0.f;
#pragma unroll
        for (int i = 0; i < 4; ++i) ss[k] += x[k][i].x * x[k][i].x + x[k][i].y * x[k][i].y + x[k][i].z * x[k][i].z + x[k][i].w * x[k][i].w;
      }
      ss[0] = wave_sum(ss[0]); ss[1] = wave_sum(ss[1]);
      rstd_x[0] = rsqrtf(ss[0] * (1.f / 1024.f) + EPS); rstd_x[1] = rsqrtf(ss[1] * (1.f / 1024.f) + EPS);
    }
#pragma unroll
    for (int k = 0; k < 2; ++k) {
      if (k >= nk) break;
      const int mk = m + k;
      const float* modh = mod + ((size_t)lh * 9 + rr[k]) * 6144;
      const float* shift = modh + ((mode == 1) ? 3 : 0) * 1024;
      const float* scale = modh + ((mode == 1) ? 4 : 1) * 1024;
#pragma unroll
      for (int i = 0; i < 4; ++i) {
        const int c = i * 256 + lane * 4;
        const float4 g = c_gpre[i], sh = c_shift[i], sc = c_scale[i];
        const float h0 = x[k][i].x * rstd_x[k] * g.x * (1.f + sc.x) + sh.x, h1 = x[k][i].y * rstd_x[k] * g.y * (1.f + sc.y) + sh.y;
        const float h2 = x[k][i].z * rstd_x[k] * g.z * (1.f + sc.z) + sh.z, h3 = x[k][i].w * rstd_x[k] * g.w * (1.f + sc.w) + sh.w;
        u32x2 w = {cvtpk(h0, h1), cvtpk(h2, h3)};
        *(u32x2*)(hbuf + (size_t)mk * 1024 + c) = w;
      }
    }
  }
#undef ROW_LOAD
}

__device__ __forceinline__ void gemm_mainloop(const u16* __restrict__ A, int lda, const u16* __restrict__ Bt, int ldb, int K, char* lds,
                                              f32x16 (&acc)[2][2], const int tid) {
  const int wid = tid >> 6, lane = tid & 63, r32 = lane & 31, hi = lane >> 5, wm = wid >> 1, wn = wid & 1;
  const int lrow = tid >> 3, lch = tid & 7;
  const u16* ag = A + (long)lrow * lda + lch * 8;
  const u16* bg = Bt + (long)lrow * ldb + lch * 8;
  const int woff = lrow * 128 + ((lch ^ ((lrow >> 1) & 7)) << 4);
  const int arow = wm * 64 + r32, asw = (arow >> 1) & 7;
  const int brow = wn * 64 + r32, bsw = (brow >> 1) & 7;
  u32x4 ra0[4], rb0[2], ra1[4], rb1[2];
#define GLOAD(kt, RA, RB) do { _Pragma("unroll") for (int i = 0; i < 4; ++i) RA[i] = *(const u32x4*)(ag + (long)(64 * i) * lda + (kt) * 64); \
    _Pragma("unroll") for (int i = 0; i < 2; ++i) RB[i] = *(const u32x4*)(bg + (long)(64 * i) * ldb + (kt) * 64); } while (0)
#define LWRITE(buf, RA, RB) do { _Pragma("unroll") for (int i = 0; i < 4; ++i) *(u32x4*)(lds + (buf) * 32768 + woff + i * 8192) = RA[i]; \
    _Pragma("unroll") for (int i = 0; i < 2; ++i) *(u32x4*)(lds + 65536 + (buf) * 16384 + woff + i * 8192) = RB[i]; } while (0)
#define COMPUTE(buf) do { const char* As = lds + (buf) * 32768; const char* Bs = lds + 65536 + (buf) * 16384; \
    _Pragma("unroll") for (int ks = 0; ks < 4; ++ks) { \
      const bf16x8 a0 = *(const bf16x8*)(As + arow * 128 + (((ks * 2 + hi) ^ asw) << 4)); \
      const bf16x8 a1 = *(const bf16x8*)(As + (arow + 32) * 128 + (((ks * 2 + hi) ^ asw) << 4)); \
      const bf16x8 b0 = *(const bf16x8*)(Bs + brow * 128 + (((ks * 2 + hi) ^ bsw) << 4)); \
      const bf16x8 b1 = *(const bf16x8*)(Bs + (brow + 32) * 128 + (((ks * 2 + hi) ^ bsw) << 4)); \
      acc[0][0] = __builtin_amdgcn_mfma_f32_32x32x16_bf16(a0, b0, acc[0][0], 0, 0, 0); \
      acc[0][1] = __builtin_amdgcn_mfma_f32_32x32x16_bf16(a0, b1, acc[0][1], 0, 0, 0); \
      acc[1][0] = __builtin_amdgcn_mfma_f32_32x32x16_bf16(a1, b0, acc[1][0], 0, 0, 0); \
      acc[1][1] = __builtin_amdgcn_mfma_f32_32x32x16_bf16(a1, b1, acc[1][1], 0, 0, 0); } } while (0)
#pragma unroll
  for (int a = 0; a < 2; ++a)
#pragma unroll
    for (int b = 0; b < 2; ++b)
#pragma unroll
      for (int r = 0; r < 16; ++r) acc[a][b][r] = 0.f;
  const int nt = K >> 6;
  GLOAD(0, ra0, rb0); GLOAD(1, ra1, rb1); LWRITE(0, ra0, rb0); __syncthreads();
  for (int kt = 0; kt < nt; kt += 2) {
    if (kt + 2 < nt) GLOAD(kt + 2, ra0, rb0);
    COMPUTE(0);
    LWRITE(1, ra1, rb1);
    __syncthreads();
    if (kt + 3 < nt) GLOAD(kt + 3, ra1, rb1);
    COMPUTE(1);
    if (kt + 2 < nt) LWRITE(0, ra0, rb0);
    __syncthreads();
  }
#undef GLOAD
#undef LWRITE
#undef COMPUTE
}

template <bool SWAP>
__device__ __forceinline__ void gemm256_mainloop(const u16* __restrict__ A, int lda, const u16* __restrict__ Bt, int ldb, int K, char* lds,
                                                 f32x16 (&acc)[4][2], const int tid) {
  const int wid = tid >> 6, lane = tid & 63, r32 = lane & 31, hi = lane >> 5, wm = wid >> 2, wn = wid & 3;
  const int srcch = (tid & 7) ^ ((tid >> 4) & 7);
  const u16* ag = A + (long)(tid >> 3) * lda + srcch * 8;
  const u16* bg = Bt + (long)(tid >> 3) * ldb + srcch * 8;
  const int swz = (r32 >> 1) & 7;
  const int aoff = (wm * 128 + r32) * 128, boff = (wn * 64 + r32) * 128;
#define ISSUE(kt, st) do { _Pragma("unroll") for (int i = 0; i < 4; ++i) { \
      __builtin_amdgcn_global_load_lds((const unsigned*)(ag + (long)(64 * i) * lda + (kt) * 64), (unsigned*)(lds + (st) * 65536 + tid * 16 + i * 8192), 16, 0, 0); \
      __builtin_amdgcn_global_load_lds((const unsigned*)(bg + (long)(64 * i) * ldb + (kt) * 64), (unsigned*)(lds + (st) * 65536 + 32768 + tid * 16 + i * 8192), 16, 0, 0); } } while (0)
#pragma unroll
  for (int a = 0; a < 4; ++a)
#pragma unroll
    for (int b = 0; b < 2; ++b)
#pragma unroll
      for (int r = 0; r < 16; ++r) acc[a][b][r] = 0.f;
  const int nt = K >> 6;
  ISSUE(0, 0);
  for (int kt = 0; kt < nt; ++kt) {
    const int st = kt & 1;
    asm volatile("s_waitcnt vmcnt(0)" ::: "memory");
    __syncthreads();
    if (kt + 1 < nt) ISSUE(kt + 1, st ^ 1);
    const char* As = lds + st * 65536 + aoff; const char* Bs = lds + st * 65536 + 32768 + boff;
    bf16x8 a0[4], b0[2], a1[4], b1[2];
#define FRAGS(ks, AF, BF) do { const int co = (((ks) * 2 + hi) ^ swz) << 4; \
      _Pragma("unroll") for (int mb = 0; mb < 4; ++mb) AF[mb] = *(const bf16x8*)(As + mb * 4096 + co); \
      _Pragma("unroll") for (int nb = 0; nb < 2; ++nb) BF[nb] = *(const bf16x8*)(Bs + nb * 4096 + co); } while (0)
#define MMAS(AF, BF) do { _Pragma("unroll") for (int mb = 0; mb < 4; ++mb) _Pragma("unroll") for (int nb = 0; nb < 2; ++nb) \
      acc[mb][nb] = SWAP ? __builtin_amdgcn_mfma_f32_32x32x16_bf16(BF[nb], AF[mb], acc[mb][nb], 0, 0, 0) \
                         : __builtin_amdgcn_mfma_f32_32x32x16_bf16(AF[mb], BF[nb], acc[mb][nb], 0, 0, 0); } while (0)
#define SB() __builtin_amdgcn_sched_barrier(0)
    FRAGS(0, a0, b0); SB();
    FRAGS(1, a1, b1); SB();
    MMAS(a0, b0); SB();
    FRAGS(2, a0, b0); SB();
    MMAS(a1, b1); SB();
    FRAGS(3, a1, b1); SB();
    MMAS(a0, b0); SB();
    MMAS(a1, b1); SB();
#undef FRAGS
#undef MMAS
#undef SB
  }
  __syncthreads();
#undef ISSUE
}

constexpr int G160_STAGE = 160 * 128 + 256 * 128;
__device__ __forceinline__ void gemm160_mainloop(const u16* __restrict__ A, int lda, const u16* __restrict__ Bt, int ldb, int K, char* lds,
                                                 f32x16 (&acc)[5], const int tid) {
  const int wid = tid >> 6, lane = tid & 63, r32 = lane & 31, hi = lane >> 5;
  const int srcch = (tid & 7) ^ ((tid >> 4) & 7);
  const u16* ag = A + (long)(tid >> 3) * lda + srcch * 8;
  const u16* bg = Bt + (long)(tid >> 3) * ldb + srcch * 8;
  const int swz = (r32 >> 1) & 7;
  const int aoff = r32 * 128, boff = 20480 + (wid * 32 + r32) * 128;
  const bool a3 = tid < 256;
#define ISSUE(kt, st) do { \
    _Pragma("unroll") for (int i = 0; i < 2; ++i) \
      __builtin_amdgcn_global_load_lds((const unsigned*)(ag + (long)(64 * i) * lda + (kt) * 64), (unsigned*)(lds + (st) * G160_STAGE + tid * 16 + i * 8192), 16, 0, 0); \
    if (a3) __builtin_amdgcn_global_load_lds((const unsigned*)(ag + (long)128 * lda + (kt) * 64), (unsigned*)(lds + (st) * G160_STAGE + tid * 16 + 16384), 16, 0, 0); \
    _Pragma("unroll") for (int i = 0; i < 4; ++i) \
      __builtin_amdgcn_global_load_lds((const unsigned*)(bg + (long)(64 * i) * ldb + (kt) * 64), (unsigned*)(lds + (st) * G160_STAGE + 20480 + tid * 16 + i * 8192), 16, 0, 0); } while (0)
#pragma unroll
  for (int a = 0; a < 5; ++a)
#pragma unroll
    for (int r = 0; r < 16; ++r) acc[a][r] = 0.f;
  const int nt = K >> 6;
  ISSUE(0, 0);
  for (int kt = 0; kt < nt; ++kt) {
    const int st = kt & 1;
    asm volatile("s_waitcnt vmcnt(0)" ::: "memory");
    __syncthreads();
    if (kt + 1 < nt) ISSUE(kt + 1, st ^ 1);
    const char* As = lds + st * G160_STAGE + aoff; const char* Bs = lds + st * G160_STAGE + boff;
    bf16x8 a0[5], b0, a1[5], b1;
#define FRAGS(ks, AF, BF) do { const int co = (((ks) * 2 + hi) ^ swz) << 4; \
      _Pragma("unroll") for (int mb = 0; mb < 5; ++mb) AF[mb] = *(const bf16x8*)(As + mb * 4096 + co); \
      BF = *(const bf16x8*)(Bs + co); } while (0)
#define MMAS(AF, BF) do { _Pragma("unroll") for (int mb = 0; mb < 5; ++mb) acc[mb] = __builtin_amdgcn_mfma_f32_32x32x16_bf16(BF, AF[mb], acc[mb], 0, 0, 0); } while (0)
#define SB() __builtin_amdgcn_sched_barrier(0)
    FRAGS(0, a0, b0); SB();
    FRAGS(1, a1, b1); SB();
    MMAS(a0, b0); SB();
    FRAGS(2, a0, b0); SB();
    MMAS(a1, b1); SB();
    FRAGS(3, a1, b1); SB();
    MMAS(a0, b0); SB();
    MMAS(a1, b1); SB();
#undef FRAGS
#undef MMAS
#undef SB
  }
  __syncthreads();
#undef ISSUE
}

using f32x4 = __attribute__((ext_vector_type(4))) float;
__device__ __forceinline__ void gemm160x16_mainloop(const u16* __restrict__ A, int lda, const u16* __restrict__ Bt, int ldb, int K, char* lds,
                                                    f32x4 (&acc)[10][2], const int tid) {
  const int wid = tid >> 6, lane = tid & 63, l16 = lane & 15, q4 = lane >> 4;
  const int srcch = (tid & 7) ^ ((tid >> 4) & 7);
  const u16* ag = A + (long)(tid >> 3) * lda + srcch * 8;
  const u16* bg = Bt + (long)(tid >> 3) * ldb + srcch * 8;
  const int swz = (l16 >> 1) & 7;
  const int aoff = l16 * 128, boff = 20480 + (wid * 32 + l16) * 128;
  const bool a3 = tid < 256;
#define ISSUE(kt, st) do { \
    _Pragma("unroll") for (int i = 0; i < 2; ++i) \
      __builtin_amdgcn_global_load_lds((const unsigned*)(ag + (long)(64 * i) * lda + (kt) * 64), (unsigned*)(lds + (st) * G160_STAGE + tid * 16 + i * 8192), 16, 0, 0); \
    if (a3) __builtin_amdgcn_global_load_lds((const unsigned*)(ag + (long)128 * lda + (kt) * 64), (unsigned*)(lds + (st) * G160_STAGE + tid * 16 + 16384), 16, 0, 0); \
    _Pragma("unroll") for (int i = 0; i < 4; ++i) \
      __builtin_amdgcn_global_load_lds((const unsigned*)(bg + (long)(64 * i) * ldb + (kt) * 64), (unsigned*)(lds + (st) * G160_STAGE + 20480 + tid * 16 + i * 8192), 16, 0, 0); } while (0)
#pragma unroll
  for (int a = 0; a < 10; ++a)
#pragma unroll
    for (int b = 0; b < 2; ++b) acc[a][b] = (f32x4){0.f, 0.f, 0.f, 0.f};
  const int nt = K >> 6;
  ISSUE(0, 0);
  for (int kt = 0; kt < nt; ++kt) {
    const int st = kt & 1;
    asm volatile("s_waitcnt vmcnt(0)" ::: "memory");
    __syncthreads();
    if (kt + 1 < nt) ISSUE(kt + 1, st ^ 1);
    const char* As = lds + st * G160_STAGE + aoff; const char* Bs = lds + st * G160_STAGE + boff;
    bf16x8 a0[10], b0[2], a1[10], b1[2];
#define FRAGS(ks, AF, BF) do { const int co = (((ks) * 4 + q4) ^ swz) << 4; \
      _Pragma("unroll") for (int mb = 0; mb < 10; ++mb) AF[mb] = *(const bf16x8*)(As + mb * 2048 + co); \
      _Pragma("unroll") for (int nb = 0; nb < 2; ++nb) BF[nb] = *(const bf16x8*)(Bs + nb * 2048 + co); } while (0)
#define MMAS(AF, BF) do { _Pragma("unroll") for (int mb = 0; mb < 10; ++mb) _Pragma("unroll") for (int nb = 0; nb < 2; ++nb) \
      acc[mb][nb] = __builtin_amdgcn_mfma_f32_16x16x32_bf16(BF[nb], AF[mb], acc[mb][nb], 0, 0, 0); } while (0)
#define SB() __builtin_amdgcn_sched_barrier(0)
    FRAGS(0, a0, b0); SB();
    FRAGS(1, a1, b1); SB();
    MMAS(a0, b0); SB();
    MMAS(a1, b1); SB();
#undef FRAGS
#undef MMAS
#undef SB
  }
  __syncthreads();
#undef ISSUE
}

__device__ __forceinline__ void gemm256x16_mainloop(const u16* __restrict__ A, int lda, const u16* __restrict__ Bt, int ldb, int K, char* lds,
                                                    f32x4 (&acc)[8][4], const int tid) {
  const int wid = tid >> 6, lane = tid & 63, l16 = lane & 15, q4 = lane >> 4, wm = wid >> 2, wn = wid & 3;
  const int srcch = (tid & 7) ^ ((tid >> 4) & 7);
  const u16* ag = A + (long)(tid >> 3) * lda + srcch * 8;
  const u16* bg = Bt + (long)(tid >> 3) * ldb + srcch * 8;
  const int swz = (l16 >> 1) & 7;
  const int aoff = (wm * 128 + l16) * 128, boff = (wn * 64 + l16) * 128;
#define ISSUE(kt, st) do { _Pragma("unroll") for (int i = 0; i < 4; ++i) { \
      __builtin_amdgcn_global_load_lds((const unsigned*)(ag + (long)(64 * i) * lda + (kt) * 64), (unsigned*)(lds + (st) * 65536 + tid * 16 + i * 8192), 16, 0, 0); \
      __builtin_amdgcn_global_load_lds((const unsigned*)(bg + (long)(64 * i) * ldb + (kt) * 64), (unsigned*)(lds + (st) * 65536 + 32768 + tid * 16 + i * 8192), 16, 0, 0); } } while (0)
#pragma unroll
  for (int a = 0; a < 8; ++a)
#pragma unroll
    for (int b = 0; b < 4; ++b) acc[a][b] = (f32x4){0.f, 0.f, 0.f, 0.f};
  const int nt = K >> 6;
  ISSUE(0, 0);
  for (int kt = 0; kt < nt; ++kt) {
    const int st = kt & 1;
    asm volatile("s_waitcnt vmcnt(0)" ::: "memory");
    __syncthreads();
    if (kt + 1 < nt) ISSUE(kt + 1, st ^ 1);
    const char* As = lds + st * 65536 + aoff; const char* Bs = lds + st * 65536 + 32768 + boff;
    bf16x8 aA[4], aB[4], bA[4];
#define LDA(ks, h, AF) do { const int co = (((ks) * 4 + q4) ^ swz) << 4; \
      _Pragma("unroll") for (int mb = 0; mb < 4; ++mb) AF[mb] = *(const bf16x8*)(As + ((h) * 4 + mb) * 2048 + co); } while (0)
#define LDB(ks, BF) do { const int co = (((ks) * 4 + q4) ^ swz) << 4; \
      _Pragma("unroll") for (int nb = 0; nb < 4; ++nb) BF[nb] = *(const bf16x8*)(Bs + nb * 2048 + co); } while (0)
#define MMAS(h, AF, BF) do { _Pragma("unroll") for (int mb = 0; mb < 4; ++mb) _Pragma("unroll") for (int nb = 0; nb < 4; ++nb) \
      acc[(h) * 4 + mb][nb] = __builtin_amdgcn_mfma_f32_16x16x32_bf16(BF[nb], AF[mb], acc[(h) * 4 + mb][nb], 0, 0, 0); } while (0)
#define SB() __builtin_amdgcn_sched_barrier(0)
    LDB(0, bA); LDA(0, 0, aA); SB();
    LDA(0, 1, aB); SB();
    MMAS(0, aA, bA); SB();
    LDA(1, 0, aA); SB();
    MMAS(1, aB, bA); SB();
    LDB(1, bA); LDA(1, 1, aB); SB();
    MMAS(0, aA, bA); SB();
    MMAS(1, aB, bA); SB();
#undef LDA
#undef LDB
#undef MMAS
#undef SB
  }
  __syncthreads();
#undef ISSUE
}

__device__ __forceinline__ int xcd_tile_index(int it) {
  return (gridDim.x == 256) ? ((it * 8 + (int)(blockIdx.x & 7)) * 32 + (int)(blockIdx.x >> 3)) : (int)(blockIdx.x + it * gridDim.x);
}
#define EPI_OFF(var, expr) long var = (long)(expr); asm volatile("" : "+v"(var) :: "memory")
#define CROW0(r) (((r) & 3) + 8 * ((r) >> 2))
#define WAVE_COORDS const int tid = opaque_tid(), wid = tid >> 6, lane = tid & 63, r32 = lane & 31, hi = lane >> 5, wm = wid >> 1, wn = wid & 1; (void)tid; (void)wm; (void)wn; (void)r32; (void)hi

__device__ __forceinline__ void phase_gemm_in(const Params& p_unused_, int l, char* lds) {
  PHASE_PARAMS;
  char* wsb = p.ws; asm volatile("" : "+s"(wsb));
  const int tid = opaque_tid(), wid = tid >> 6, lane = tid & 63, l16 = lane & 15, q4 = lane >> 4;
  const u16* h = (const u16*)(wsb + OFF_C);
  const u16* wt = (const u16*)(wsb + OFF_W + (size_t)l * WL_SIZE + WL_IN);
  u16* proj = (u16*)(wsb + A_PROJ);
  for (int it = 0;; ++it) {
    const int t = xcd_tile_index(it);
    if (t >= 256 * 5) break;
    const int mt = (t / 40) * 8 + (t & 7), nt = (t >> 3) % 5;
    f32x4 acc[10][2];
    gemm160x16_mainloop(h + (size_t)mt * 160 * 1024, 1024, wt + (size_t)nt * 256 * 1024, 1024, 1024, lds, acc, tid);
    const int col = nt * 256 + wid * 32 + q4 * 4;
#pragma unroll
    for (int mb = 0; mb < 10; ++mb) {
      EPI_OFF(eo, (long)(mt * 160 + mb * 16 + l16) * IN_COLS + col);
#pragma unroll
      for (int nb = 0; nb < 2; ++nb)
        if (col + 16 * nb < IN_COLS) {
          u32x2 w = {cvtpk(acc[mb][nb][0], acc[mb][nb][1]), cvtpk(acc[mb][nb][2], acc[mb][nb][3])};
          *(u32x2*)(proj + eo + 16 * nb) = w;
        }
    }
  }
}

__device__ __forceinline__ void phase_gemm_mix(const Params& p_unused_, int l, char* lds) {
  PHASE_PARAMS;
  char* wsb = p.ws; asm volatile("" : "+s"(wsb));
  WAVE_COORDS;
  char* wl = wsb + OFF_W + (size_t)l * WL_SIZE;
  const u16* proj = (const u16*)(wsb + A_PROJ);
  u16* mix = (u16*)(wsb + OFF_C);
  const float2* tab = (const float2*)(wsb + OFF_TAB);
  {
    const int l16 = lane & 15, q4 = lane >> 4, wm2 = wid >> 2, wn2 = wid & 3;
    u16* kv = (u16*)(wsb + B_KV);
    const u16* ckv = (const u16*)(wsb + A_CKV);
    const u16* wkvb = (const u16*)(wl + WL_KVB);
    for (int it = 0;; ++it) {
      const int t = xcd_tile_index(it);
      if (t >= 176 * 4) break;
      const int mt = (t >> 5) * 8 + (t & 7), nt = (t >> 3) & 3;
      f32x4 acc[8][4];
      gemm256x16_mainloop(ckv + (size_t)mt * 256 * 128, 128, wkvb + (size_t)nt * 256 * 128, 128, 128, lds, acc, tid);
#pragma unroll
      for (int mb = 0; mb < 8; ++mb) {
        EPI_OFF(eo, (long)(mt * 256 + wm2 * 128 + mb * 16 + l16) * 1024 + nt * 256 + wn2 * 64 + q4 * 4);
#pragma unroll
        for (int nb = 0; nb < 4; ++nb) {
          u32x2 w = {cvtpk(acc[mb][nb][0], acc[mb][nb][1]), cvtpk(acc[mb][nb][2], acc[mb][nb][3])};
          *(u32x2*)(kv + eo + nb * 16) = w;
        }
      }
    }
  }
  for (int it = 0;; ++it) {
    const int ts = xcd_tile_index(it);
    if (ts >= 1600) break;
    const int t = ts < 960 ? ts : ts + 1408;
    f32x16 acc[2][2];
    if (t < 960) {
      const int mt = t / 6, nt = t % 6;
      gemm_mainloop((const u16*)(wsb + A_QAN) + (size_t)mt * 256 * 256, 256, (const u16*)(wl + WL_QB) + (size_t)nt * 128 * 256, 256, 256, lds, acc, tid);
      u16* q = (u16*)(wsb + B_Q);
      const bool lat = mt >= 32;
#pragma unroll
      for (int mb = 0; mb < 2; ++mb)
#pragma unroll
        for (int nb = 0; nb < 2; ++nb) {
          const int n = nt * 128 + wn * 64 + nb * 32 + r32;
          const bool ropeblk = ((n >> 5) % 3) == 2;
          int m0q = mt * 256 + wm * 64 + mb * 32 + 4 * hi; asm volatile("" : "+v"(m0q) :: "memory");
          const long eo = (long)m0q * 768 + n;
#pragma unroll
          for (int r = 0; r < 16; ++r) {
            const int m = m0q + CROW0(r);
            float v = acc[mb][nb][r];
            if (lat && ropeblk) {
              const float pv = __shfl_xor(v, 8);
              const int s = (m - M_CTX) & 4095;
              const int axis = r32 >> 4, half = (r32 >> 3) & 1, f = r32 & 7;
              const int pos = axis ? (s & 63) : (s >> 6);
              const float2 cs = tab[pos * 8 + f];
              v = half ? (v * cs.x + pv * cs.y) : (v * cs.x - pv * cs.y);
            }
            q[eo + CROW0(r) * 768] = f2bf(v);
          }
        }
    } else if (t < 2368) {
      const int tt = t - 960, mt = tt >> 3, nt = tt & 7;
      gemm_mainloop((const u16*)(wsb + A_CKV) + (size_t)mt * 256 * 128, 128, (const u16*)(wl + WL_KVB) + (size_t)nt * 128 * 128, 128, 128, lds, acc, tid);
      u16* kv = (u16*)(wsb + B_KV);
#pragma unroll
      for (int mb = 0; mb < 2; ++mb)
#pragma unroll
        for (int nb = 0; nb < 2; ++nb) {
          const int n = nt * 128 + wn * 64 + nb * 32 + r32;
          { EPI_OFF(eo, (long)(mt * 256 + wm * 64 + mb * 32 + 4 * hi) * 1024 + n);
            _Pragma("unroll") for (int r = 0; r < 16; ++r) kv[eo + CROW0(r) * 1024] = f2bf(acc[mb][nb][r]); }
        }
    } else if (t < 2688) {
      const int tt = t - 2368, mt = tt >> 1, nt = tt & 1;
      gemm_mainloop((const u16*)(wsb + A_DPOOL) + (size_t)mt * 256 * 256, 256, (const u16*)(wl + WL_POOL) + (size_t)nt * 128 * 256, 256, 256, lds, acc, tid);
#pragma unroll
      for (int mb = 0; mb < 2; ++mb)
#pragma unroll
        for (int nb = 0; nb < 2; ++nb) {
          const int n = nt * 128 + wn * 64 + nb * 32 + r32;
          const float ps = p.pool_scale[l * 256 + n];
          { EPI_OFF(eo, (long)(mt * 256 + wm * 64 + mb * 32 + 4 * hi) * 1024 + 512 + n);
            _Pragma("unroll") for (int r = 0; r < 16; ++r) mix[eo + CROW0(r) * 1024] = f2bf(acc[mb][nb][r] * ps); }
        }
    } else {
      const int tt = t - 2688, h = tt / 80, mt = tt % 80;
      gemm_mainloop((const u16*)(wsb + A_VT) + ((size_t)h * 20480 + (size_t)mt * 256) * 128, 128, (const u16*)(wl + WL_SGU) + (size_t)h * 128 * 128, 128, 128, lds, acc, tid);
      const int chunk = mt * 4 + wm;
#pragma unroll
      for (int nb = 0; nb < 2; ++nb) {
        const int qq = wn * 64 + nb * 32 + r32;
        const float bias = p.b_sgu[((size_t)l * 4 + h) * 128 + qq];
        const size_t tok = (size_t)chunk * 128 + qq;
#pragma unroll
        for (int mb = 0; mb < 2; ++mb)
#pragma unroll
          for (int j = 0; j < 4; ++j) {
            const int d0 = mb * 32 + 8 * j + 4 * hi;
            const u32x2 uw = *(const u32x2*)(proj + tok * IN_COLS + 672 + h * 64 + d0);
            const float o0 = (acc[mb][nb][4 * j + 0] + bias) * bflo(uw[0]), o1 = (acc[mb][nb][4 * j + 1] + bias) * bfhi(uw[0]);
            const float o2 = (acc[mb][nb][4 * j + 2] + bias) * bflo(uw[1]), o3 = (acc[mb][nb][4 * j + 3] + bias) * bfhi(uw[1]);
            u32x2 w = {cvtpk(o0, o1), cvtpk(o2, o3)};
            *(u32x2*)(mix + tok * 1024 + 768 + h * 64 + d0) = w;
          }
      }
    }
  }
}

__device__ __forceinline__ void phase_gemm_f32out(const Params& p_unused_, size_t a_off, int K, size_t w_off, char* lds) {
  PHASE_PARAMS;
  char* wsb = p.ws; asm volatile("" : "+s"(wsb));
  const int tid = opaque_tid(), wid = tid >> 6, lane = tid & 63, l16 = lane & 15, q4 = lane >> 4;
  u16* obuf = (u16*)(wsb + OFF_B);
  const u16* A = (const u16*)(wsb + a_off); const u16* wt = (const u16*)(wsb + w_off);
  for (int it = 0;; ++it) {
    const int t = xcd_tile_index(it);
    if (t >= 256 * 4) break;
    const int mt = (t >> 5) * 8 + (t & 7), nt = (t >> 3) & 3;
    f32x4 acc[10][2];
    gemm160x16_mainloop(A + (size_t)mt * 160 * K, K, wt + (size_t)nt * 256 * K, K, K, lds, acc, tid);
#pragma unroll
    for (int mb = 0; mb < 10; ++mb) {
      EPI_OFF(eo, (long)(mt * 160 + mb * 16 + l16) * 1024 + nt * 256 + wid * 32 + q4 * 4);
#pragma unroll
      for (int nb = 0; nb < 2; ++nb) {
        u32x2 w = {cvtpk(acc[mb][nb][0], acc[mb][nb][1]), cvtpk(acc[mb][nb][2], acc[mb][nb][3])};
        *(u32x2*)(obuf + eo + 16 * nb) = w;
      }
    }
  }
}

constexpr int ZP = 264;
__device__ __forceinline__ void unpack8(const u32x4 w, float* f) {
  f[0] = bflo(w[0]); f[1] = bfhi(w[0]); f[2] = bflo(w[1]); f[3] = bfhi(w[1]); f[4] = bflo(w[2]); f[5] = bfhi(w[2]); f[6] = bflo(w[3]); f[7] = bfhi(w[3]);
}
__device__ __forceinline__ void phase_gemm_up(const Params& p_unused_, int l, char* lds) {
  PHASE_PARAMS;
  char* wsb = p.ws; asm volatile("" : "+s"(wsb));
  const int tid = opaque_tid(), wid = tid >> 6, lane = tid & 63, r32 = lane & 31, hi = lane >> 5, wm = wid >> 2, wn = wid & 3;
  const u16* h = (const u16*)(wsb + OFF_C);
  const u16* wt = (const u16*)(wsb + OFF_W + (size_t)l * WL_SIZE + WL_UP);
  u16* act_ = (u16*)(wsb + OFF_A);
  u16* halo_ = (u16*)(wsb + OFF_B);
  u16* zs = (u16*)lds;
  const float* cw_ = p.conv_w + (size_t)l * 3 * 5632;
  const float* cb_ = p.conv_b + (size_t)l * 5632;
  for (int it = 0;; ++it) {
    const int t = xcd_tile_index(it);
    if (t >= 160 * 22) break;
    const int mt = (t / 176) * 8 + (t & 7), nt = (t >> 3) % 22;
    f32x4 acc[8][4];
    gemm256x16_mainloop(h + (size_t)mt * 256 * 1024, 1024, wt + (size_t)nt * 256 * 1024, 1024, 1024, lds, acc, tid);
    {
      const int l16 = lane & 15, q4 = lane >> 4;
#pragma unroll
      for (int mb = 0; mb < 8; ++mb) {
        EPI_OFF(zo, (wm * 128 + mb * 16 + l16) * ZP + wn * 32 + q4 * 4);
#pragma unroll
        for (int nb = 0; nb < 4; ++nb) {
          u32x2 w = {cvtpk(acc[mb][nb][0], acc[mb][nb][1]), cvtpk(acc[mb][nb][2], acc[mb][nb][3])};
          *(u32x2*)(zs + zo + (nb >> 1) * 128 + (nb & 1) * 16) = w;
        }
      }
    }
    const int fch = tid & 15, rg = tid >> 4;
    int fg = nt * 128 + fch * 8;
    asm volatile("" : "+v"(fg) :: "memory");
    const float* cw = cw_; const float* cb = cb_; u16* act = act_; u16* halo = halo_;
    asm volatile("" : "+v"(cw), "+v"(cb), "+v"(act), "+v"(halo));
    const bool lat = mt >= 32;
    const bool top_zero = !lat || (((mt - 32) & 15) == 0), bot_zero = !lat || (((mt - 32) & 15) == 15);
    float cwg[3][8], cwv[3][8], cbg[8], cbv[8];
#pragma unroll
    for (int tp = 0; tp < 3; ++tp) {
      const float4 g0 = *(const float4*)(cw + tp * 5632 + fg), g1 = *(const float4*)(cw + tp * 5632 + fg + 4);
      const float4 v0 = *(const float4*)(cw + tp * 5632 + DFF + fg), v1 = *(const float4*)(cw + tp * 5632 + DFF + fg + 4);
      cwg[tp][0] = g0.x; cwg[tp][1] = g0.y; cwg[tp][2] = g0.z; cwg[tp][3] = g0.w; cwg[tp][4] = g1.x; cwg[tp][5] = g1.y; cwg[tp][6] = g1.z; cwg[tp][7] = g1.w;
      cwv[tp][0] = v0.x; cwv[tp][1] = v0.y; cwv[tp][2] = v0.z; cwv[tp][3] = v0.w; cwv[tp][4] = v1.x; cwv[tp][5] = v1.y; cwv[tp][6] = v1.z; cwv[tp][7] = v1.w;
    }
    {
      const float4 g0 = *(const float4*)(cb + fg), g1 = *(const float4*)(cb + fg + 4), v0 = *(const float4*)(cb + DFF + fg), v1 = *(const float4*)(cb + DFF + fg + 4);
      cbg[0] = g0.x; cbg[1] = g0.y; cbg[2] = g0.z; cbg[3] = g0.w; cbg[4] = g1.x; cbg[5] = g1.y; cbg[6] = g1.z; cbg[7] = g1.w;
      cbv[0] = v0.x; cbv[1] = v0.y; cbv[2] = v0.z; cbv[3] = v0.w; cbv[4] = v1.x; cbv[5] = v1.y; cbv[6] = v1.z; cbv[7] = v1.w;
    }
    __syncthreads();
    const int r0 = rg * 8;
    const u16* zg = zs + fch * 8;
    float pg[8], pv[8], cg[8], cv[8], ng[8], nv[8];
    if (r0 > 0) { unpack8(*(const u32x4*)(zg + (r0 - 1) * ZP), pg); unpack8(*(const u32x4*)(zg + (r0 - 1) * ZP + 128), pv); }
    else {
#pragma unroll
      for (int e = 0; e < 8; ++e) { pg[e] = 0.f; pv[e] = 0.f; }
    }
    unpack8(*(const u32x4*)(zg + r0 * ZP), cg); unpack8(*(const u32x4*)(zg + r0 * ZP + 128), cv);
#pragma unroll
    for (int j = 0; j < 8; ++j) {
      const int row = r0 + j;
      if (row < 255) { unpack8(*(const u32x4*)(zg + (row + 1) * ZP), ng); unpack8(*(const u32x4*)(zg + (row + 1) * ZP + 128), nv); }
      else {
#pragma unroll
        for (int e = 0; e < 8; ++e) { ng[e] = 0.f; nv[e] = 0.f; }
      }
      if (lat && (row < 2 || row >= 254)) {
        const int hr = row < 2 ? row : row - 252;
        *(u32x4*)(halo + ((size_t)mt * 4 + hr) * 5632 + fg) = *(const u32x4*)(zg + row * ZP);
        *(u32x4*)(halo + ((size_t)mt * 4 + hr) * 5632 + DFF + fg) = *(const u32x4*)(zg + row * ZP + 128);
      }
      const bool skip = (row == 0 && !top_zero) || (row == 255 && !bot_zero);
      if (!skip) {
        float o[8];
#pragma unroll
        for (int e = 0; e < 8; ++e) {
          const float gg = cwg[0][e] * pg[e] + cwg[1][e] * cg[e] + cwg[2][e] * ng[e] + cbg[e];
          const float vv = cwv[0][e] * pv[e] + cwv[1][e] * cv[e] + cwv[2][e] * nv[e] + cbv[e];
          o[e] = silu_f(gg) * vv;
        }
        u32x4 w = {cvtpk(o[0], o[1]), cvtpk(o[2], o[3]), cvtpk(o[4], o[5]), cvtpk(o[6], o[7])};
        *(u32x4*)(act + (size_t)(mt * 256 + row) * DFF + fg) = w;
      }
#pragma unroll
      for (int e = 0; e < 8; ++e) { pg[e] = cg[e]; pv[e] = cv[e]; cg[e] = ng[e]; cv[e] = nv[e]; }
    }
    __syncthreads();
  }
}

__device__ __forceinline__ void phase_fixup(const Params& p_unused_, int l) {
  PHASE_PARAMS;
  char* wsb = p.ws; asm volatile("" : "+s"(wsb));
  const int tid = opaque_tid();
  u16* act = (u16*)(wsb + OFF_A);
  const u16* halo = (const u16*)(wsb + OFF_B);
  const float* cw = p.conv_w + (size_t)l * 3 * 5632;
  const float* cb = p.conv_b + (size_t)l * 5632;
  for (int u = blockIdx.x; u < 256; u += gridDim.x) {
    const int mt = 32 + (u >> 1), e = u & 1;
    const int row = e ? 255 : 0, m = mt * 256 + row, s = (m - M_CTX) & 4095;
    if ((e == 0 && s == 0) || (e == 1 && s == S_LAT - 1)) continue;
    const u16* up = e == 0 ? halo + ((size_t)(mt - 1) * 4 + 3) * 5632 : halo + ((size_t)mt * 4 + 2) * 5632;
    const u16* own = e == 0 ? halo + ((size_t)mt * 4 + 0) * 5632 : halo + ((size_t)mt * 4 + 3) * 5632;
    const u16* dn = e == 0 ? halo + ((size_t)mt * 4 + 1) * 5632 : halo + ((size_t)(mt + 1) * 4 + 0) * 5632;
    for (int f = tid; f < DFF; f += NTHR) {
      const float gg = cw[f] * bf2f(up[f]) + cw[5632 + f] * bf2f(own[f]) + cw[2 * 5632 + f] * bf2f(dn[f]) + cb[f];
      const float vv = cw[DFF + f] * bf2f(up[DFF + f]) + cw[5632 + DFF + f] * bf2f(own[DFF + f]) + cw[2 * 5632 + DFF + f] * bf2f(dn[DFF + f]) + cb[DFF + f];
      act[(size_t)m * DFF + f] = f2bf(silu_f(gg) * vv);
    }
  }
}

constexpr int VSP = 264;
__device__ __forceinline__ void phase_mid(const Params& p_unused_, int l, char* lds) {
  PHASE_PARAMS;
  char* wsb = p.ws; asm volatile("" : "+s"(wsb));
  const int tid = opaque_tid(), wid = tid >> 6, lane = tid & 63;
  const u16* proj = (const u16*)(wsb + A_PROJ);
  u16* qan = (u16*)(wsb + A_QAN);
  u16* ckva = (u16*)(wsb + A_CKV);
  u16* dpool = (u16*)(wsb + A_DPOOL);
  u16* vT = (u16*)(wsb + A_VT);
  u16* krope = (u16*)(wsb + B_KR);
  const float2* tab = (const float2*)(wsb + OFF_TAB);
  u16* vs = (u16*)lds;
  const float4 c_gq = *(const float4*)(p.g_q_a + l * 256 + lane * 4), c_gs = *(const float4*)(p.g_sgu + l * 256 + lane * 4);
  const float2 c_gk = *(const float2*)(p.g_kv_a + l * 128 + lane * 2);
  for (int u = blockIdx.x; u < 704; u += gridDim.x) {
    if (u < 640) {
      const int chunk = u >> 1, half = u & 1;
      float a0 = 0.f, a1 = 0.f, a2 = 0.f, a3 = 0.f; int pw_lo = 0, pw_hi = 0;
      for (int tl = wid * 8; tl < wid * 8 + 8; ++tl) {
        const int m = u * 64 + tl;
        const bool ctx = m < M_CTX;
        int b, s, S, kvrow;
        if (ctx) { b = m >> 8; s = m & 255; S = S_CTX; kvrow = m; }
        else { const int mm = m - M_CTX; b = mm >> 12; s = mm & 4095; S = S_LAT; kvrow = M_CTX + b * T_LAT + PAST + s; }
        const u16* pr = proj + (size_t)m * IN_COLS;
        {
          const u32x2 w = *(const u32x2*)(pr + lane * 4);
          const float x0 = bflo(w[0]), x1 = bfhi(w[0]), x2 = bflo(w[1]), x3 = bfhi(w[1]);
          const float ss = wave_sum(x0 * x0 + x1 * x1 + x2 * x2 + x3 * x3);
          const float rstd = rsqrtf(ss * (1.f / 256.f) + EPS);
          const float4 g = c_gq;
          u32x2 o = {cvtpk(x0 * rstd * g.x, x1 * rstd * g.y), cvtpk(x2 * rstd * g.z, x3 * rstd * g.w)};
          *(u32x2*)(qan + (size_t)m * 256 + lane * 4) = o;
        }
        {
          const unsigned w = *(const unsigned*)(pr + 256 + lane * 2);
          const float x0 = bflo(w), x1 = bfhi(w);
          const float ss = wave_sum(x0 * x0 + x1 * x1);
          const float rstd = rsqrtf(ss * (1.f / 128.f) + EPS);
          const float2 g = c_gk;
          const float y0 = x0 * rstd * g.x, y1 = x1 * rstd * g.y;
          *(unsigned*)(ckva + (size_t)kvrow * 128 + lane * 2) = cvtpk(y0, y1);
          if (ctx) *(float2*)(p.out + OUT_CKV + (((size_t)b * 2 + l) * 256 + s) * 128 + lane * 2) = make_float2(y0, y1);
        }
        {
          const float x = bf2f(pr[384 + (lane & 31)]);
          const float pv = __shfl_xor(x, 8);
          float y = x;
          if (!ctx) {
            const int rr = lane & 31, axis = rr >> 4, half = (rr >> 3) & 1, f = rr & 7;
            const int pos = axis ? (s & 63) : (s >> 6);
            const float2 cs = tab[pos * 8 + f];
            y = half ? (x * cs.x + pv * cs.y) : (x * cs.x - pv * cs.y);
          }
          if (lane < 32) {
            krope[(size_t)kvrow * 32 + lane] = f2bf(y);
            if (ctx) p.out[OUT_KR + (((size_t)b * 2 + l) * 256 + s) * 32 + lane] = x;
          }
        }
        {
          const int g = lane >> 4, half = 1 << g;
          const int lo = max(s - half, 0), hi_ = min(s + half, S);
          const u16* pb = proj + (size_t)(m - s) * IN_COLS + 416 + lane * 4;
          for (int t = max(pw_hi, lo); t < hi_; ++t) {
            const u32x2 w = *(const u32x2*)(pb + (size_t)t * IN_COLS);
            a0 += bflo(w[0]); a1 += bfhi(w[0]); a2 += bflo(w[1]); a3 += bfhi(w[1]);
          }
          for (int t = pw_lo; t < min(lo, pw_hi); ++t) {
            const u32x2 w = *(const u32x2*)(pb + (size_t)t * IN_COLS);
            a0 -= bflo(w[0]); a1 -= bfhi(w[0]); a2 -= bflo(w[1]); a3 -= bfhi(w[1]);
          }
          pw_lo = lo; pw_hi = hi_;
          const u32x2 w = *(const u32x2*)(pb + (size_t)s * IN_COLS);
          const float inv = __builtin_amdgcn_rcpf((float)(hi_ - lo));
          u32x2 o = {cvtpk(a0 * inv - bflo(w[0]), a1 * inv - bfhi(w[0])), cvtpk(a2 * inv - bflo(w[1]), a3 * inv - bfhi(w[1]))};
          *(u32x2*)(dpool + (size_t)m * 256 + lane * 4) = o;
        }
        {
          const u32x2 w = *(const u32x2*)(pr + 928 + lane * 4);
          const float x0 = bflo(w[0]), x1 = bfhi(w[0]), x2 = bflo(w[1]), x3 = bfhi(w[1]);
          const float ss = wave_sum(x0 * x0 + x1 * x1 + x2 * x2 + x3 * x3);
          const float rstd = rsqrtf(ss * (1.f / 256.f) + EPS);
          const float4 g = c_gs;
          u32x2 o = {cvtpk(x0 * rstd * g.x, x1 * rstd * g.y), cvtpk(x2 * rstd * g.z, x3 * rstd * g.w)};
          *(u32x2*)(vs + tl * VSP + lane * 4) = o;
        }
      }
      __syncthreads();
#pragma unroll 1
      for (int i = 0; i < 4; ++i) {
        const int hd = (tid >> 3) + 64 * i, ps = tid & 7, h = hd >> 6, d = hd & 63;
        u16 e[8];
#pragma unroll
        for (int j = 0; j < 8; ++j) e[j] = vs[(ps * 8 + j) * VSP + hd];
        u32x4 w = {(unsigned)e[0] | ((unsigned)e[1] << 16), (unsigned)e[2] | ((unsigned)e[3] << 16), (unsigned)e[4] | ((unsigned)e[5] << 16), (unsigned)e[6] | ((unsigned)e[7] << 16)};
        *(u32x4*)(vT + (((size_t)h * 320 + chunk) * 64 + d) * 128 + half * 64 + ps * 8) = w;
      }
      __syncthreads();
    } else {
      const int uu = u - 640, b = uu >> 3, t0 = (uu & 7) * 64;
      for (int tl = wid; tl < 64; tl += 8) {
        const int t = t0 + tl; const size_t kvrow = (size_t)M_CTX + (size_t)b * T_LAT + t;
        const float2 v = *(const float2*)(p.cache_ckv + (((size_t)b * 2 + l) * PAST + t) * 128 + lane * 2);
        *(unsigned*)(ckva + kvrow * 128 + lane * 2) = cvtpk(v.x, v.y);
        if (lane < 32) krope[kvrow * 32 + lane] = f2bf(p.cache_krope[(((size_t)b * 2 + l) * PAST + t) * 32 + lane]);
      }
    }
  }
}

constexpr int SHM_V = 64 * 128 * 2, SHM_K = 64 * 128 * 2;
constexpr float ATT_SCALE = 0.10206207261596575f;
constexpr float ATT_THR = 8.f;
#define KSWZ(row, colB) ((row) * 256 + ((colB) ^ (((row) & 15) << 4)))
#define SBAR() __builtin_amdgcn_sched_barrier(0)

__device__ __forceinline__ void partialSM(f32x16& p0, f32x16& p1, float& m_reg, float& mn, float& alpha) {
  constexpr float C = ATT_SCALE * 1.4426950408889634f;
  float pmax = p0[0];
#pragma unroll
  for (int r = 1; r < 16; ++r) pmax = fmaxf(pmax, p0[r]);
#pragma unroll
  for (int r = 0; r < 16; ++r) pmax = fmaxf(pmax, p1[r]);
  { auto rr = __builtin_amdgcn_permlane32_swap(__float_as_uint(pmax), __float_as_uint(pmax), false, false);
    pmax = fmaxf(__uint_as_float(rr[0]), __uint_as_float(rr[1])); }
  if (__builtin_expect(__all(pmax - m_reg <= ATT_THR / ATT_SCALE), 1)) { mn = m_reg; alpha = 1.f; }
  else { mn = fmaxf(m_reg, pmax); alpha = __builtin_amdgcn_exp2f((m_reg - mn) * C); m_reg = mn; }
  const float mnC = -mn * C;
#pragma unroll
  for (int r = 0; r < 16; ++r) p0[r] = fmaf(p0[r], C, mnC);
#pragma unroll
  for (int r = 0; r < 16; ++r) p1[r] = fmaf(p1[r], C, mnC);
#pragma unroll
  for (int r = 0; r < 16; ++r) p0[r] = __builtin_amdgcn_exp2f(p0[r]);
}
__device__ __forceinline__ void finishSM(f32x16& p0, f32x16& p1, float alpha, float& l_reg, bf16x8& pa0, bf16x8& pa1, bf16x8& pa2, bf16x8& pa3) {
#pragma unroll
  for (int r = 0; r < 16; ++r) p1[r] = __builtin_amdgcn_exp2f(p1[r]);
  float ps = 0;
#pragma unroll
  for (int r = 0; r < 16; ++r) ps += p0[r];
#pragma unroll
  for (int r = 0; r < 16; ++r) ps += p1[r];
  { auto rr = __builtin_amdgcn_permlane32_swap(__float_as_uint(ps), __float_as_uint(ps), false, false);
    ps = __uint_as_float(rr[0]) + __uint_as_float(rr[1]); }
  l_reg = l_reg * alpha + ps;
#define PK4(P, BASE, OUT) do { unsigned a0 = cvtpk(P[BASE + 0], P[BASE + 1]), a1 = cvtpk(P[BASE + 2], P[BASE + 3]);   \
    unsigned b0 = cvtpk(P[BASE + 4], P[BASE + 5]), b1 = cvtpk(P[BASE + 6], P[BASE + 7]);                              \
    auto r0 = __builtin_amdgcn_permlane32_swap(a0, b0, false, false); auto r1 = __builtin_amdgcn_permlane32_swap(a1, b1, false, false); \
    u32x4 w = {r0[0], r1[0], r0[1], r1[1]}; OUT = *reinterpret_cast<bf16x8*>(&w); } while (0)
  PK4(p0, 0, pa0); PK4(p0, 8, pa1); PK4(p1, 0, pa2); PK4(p1, 8, pa3);
#undef PK4
}
__device__ __forceinline__ void qkt(f32x16& p0, f32x16& p1, const char* Ks, const bf16x8* qr, int r32, int hi) {
#pragma unroll
  for (int r = 0; r < 16; ++r) { p0[r] = 0.f; p1[r] = 0.f; }
#pragma unroll
  for (int d0 = 0; d0 < 6; ++d0) { const int cb = (d0 * 16 + hi * 8) * 2;
    const bf16x8 b0 = *reinterpret_cast<const bf16x8*>(Ks + KSWZ(r32, cb));
    const bf16x8 b1 = *reinterpret_cast<const bf16x8*>(Ks + KSWZ(32 + r32, cb));
    p0 = __builtin_amdgcn_mfma_f32_32x32x16_bf16(b0, qr[d0], p0, 0, 0, 0);
    p1 = __builtin_amdgcn_mfma_f32_32x32x16_bf16(b1, qr[d0], p1, 0, 0, 0); }
}
__device__ __forceinline__ int v_st(int k, int c) { const int kk = (k & ~0xC) | ((k & 4) << 1) | ((k & 8) >> 1); return ((kk >> 3) * 4 + (c >> 5)) * 512 + ((kk & 7) * 32 + (c & 31)) * 2; }
__device__ __forceinline__ int v_rd_base(int lane) { return ((lane & 3) << 3) | (((lane >> 2) & 3) << 6) | (((lane >> 4) & 1) << 5) | (((lane >> 5) & 1) << 8); }
constexpr int v_rd_off(int d0, int ks, int half) { return d0 * 512 + ks * 4096 + half * 2048; }
template <int OFF> __device__ __forceinline__ s16x4 tr_read(int vb) {
  s16x4 r; asm volatile("ds_read_b64_tr_b16 %0, %1 offset:%2" : "=&v"(r) : "v"(vb), "i"(OFF) : "memory"); return r;
}
template <int D0> __device__ __forceinline__ void pv_one(f32x16& od, int vb, bf16x8 pa0, bf16x8 pa1, bf16x8 pa2, bf16x8 pa3) {
  const s16x4 l0 = tr_read<v_rd_off(D0, 0, 0)>(vb), h0 = tr_read<v_rd_off(D0, 0, 1)>(vb), l1 = tr_read<v_rd_off(D0, 1, 0)>(vb), h1 = tr_read<v_rd_off(D0, 1, 1)>(vb);
  const s16x4 l2 = tr_read<v_rd_off(D0, 2, 0)>(vb), h2 = tr_read<v_rd_off(D0, 2, 1)>(vb), l3 = tr_read<v_rd_off(D0, 3, 0)>(vb), h3 = tr_read<v_rd_off(D0, 3, 1)>(vb);
  asm volatile("s_waitcnt lgkmcnt(0)" ::: "memory"); SBAR();
#define PK(L, H) (bf16x8){L[0], L[1], L[2], L[3], H[0], H[1], H[2], H[3]}
  od = __builtin_amdgcn_mfma_f32_32x32x16_bf16(pa0, PK(l0, h0), od, 0, 0, 0);
  od = __builtin_amdgcn_mfma_f32_32x32x16_bf16(pa1, PK(l1, h1), od, 0, 0, 0);
  od = __builtin_amdgcn_mfma_f32_32x32x16_bf16(pa2, PK(l2, h2), od, 0, 0, 0);
  od = __builtin_amdgcn_mfma_f32_32x32x16_bf16(pa3, PK(l3, h3), od, 0, 0, 0);
#undef PK
}
__device__ __forceinline__ void pv_d0(f32x16* o, int vb, bf16x8 pa0, bf16x8 pa1, bf16x8 pa2, bf16x8 pa3) {
  pv_one<0>(o[0], vb, pa0, pa1, pa2, pa3); pv_one<1>(o[1], vb, pa0, pa1, pa2, pa3);
}

__device__ __forceinline__ void attn_body(const u16* __restrict__ Qb, const u16* __restrict__ Kh, const u16* __restrict__ KRh,
                                          const u16* __restrict__ Vh, u16* __restrict__ Ob, int seq, char* lds) {
  const int tid = opaque_tid(), wid = tid >> 6, lane = tid & 63, r32 = lane & 31, hi = lane >> 5;
  char* V_lds = lds; char* K_lds = lds + 2 * SHM_V;
  float* ws = (float*)(lds + 2 * SHM_V + 2 * SHM_K) + wid * 64; float* li_l = ws; float* al_l = ws + 32;
  float m_reg = -1e30f, l_reg = 0; f32x16 o[2]; bf16x8 qr[6];
#pragma unroll
  for (int r = 0; r < 16; ++r) { o[0][r] = 0.f; o[1][r] = 0.f; }
  const u16* Qw = Qb + (long)(wid * 32 + r32) * 768 + hi * 8;
#pragma unroll
  for (int d0 = 0; d0 < 6; ++d0) qr[d0] = *reinterpret_cast<const bf16x8*>(Qw + d0 * 16);
  const int sr = tid >> 4, c16 = tid & 15;
  const u16* kp; int kstr;
  if (c16 < 8) { kp = Kh + (long)sr * 1024 + c16 * 8; kstr = 1024; } else { kp = KRh + (long)sr * 32 + ((c16 - 8) & 3) * 8; kstr = 32; }
  const int kst0 = KSWZ(sr, c16 * 16), kst1 = KSWZ(32 + sr, c16 * 16);
  const int vkey = tid >> 3, vc = (tid & 7) * 8; const u16* vp = Vh + (long)vkey * 1024 + vc; const int vst = v_st(vkey, vc);
  const int vb0 = (int)(uintptr_t)V_lds + v_rd_base(lane);
  bf16x8 sv0, sk00, sk01, sv1, sk10, sk11;
#define SLOAD0(k0) do { sv0 = *(const bf16x8*)(vp + (long)(k0) * 1024); sk00 = *(const bf16x8*)(kp + (long)(k0) * kstr); sk01 = *(const bf16x8*)(kp + (long)((k0) + 32) * kstr); } while (0)
#define SLOAD1(k0) do { sv1 = *(const bf16x8*)(vp + (long)(k0) * 1024); sk10 = *(const bf16x8*)(kp + (long)(k0) * kstr); sk11 = *(const bf16x8*)(kp + (long)((k0) + 32) * kstr); } while (0)
#define SWRITE0(b) do { *(bf16x8*)(V_lds + (b) * SHM_V + vst) = sv0; *(bf16x8*)(K_lds + (b) * SHM_K + kst0) = sk00; *(bf16x8*)(K_lds + (b) * SHM_K + kst1) = sk01; } while (0)
#define SWRITE1(b) do { *(bf16x8*)(V_lds + (b) * SHM_V + vst) = sv1; *(bf16x8*)(K_lds + (b) * SHM_K + kst0) = sk10; *(bf16x8*)(K_lds + (b) * SHM_K + kst1) = sk11; } while (0)
#define SWAIT() asm volatile("s_waitcnt vmcnt(3)" ::: "memory")
#define RESC(a) do { if (__any((a) < 1.f)) { if (hi == 0) al_l[r32] = (a); asm volatile("s_waitcnt lgkmcnt(0)" ::: "memory"); \
    _Pragma("unroll") for (int d = 0; d < 2; ++d) _Pragma("unroll") for (int r = 0; r < 16; ++r) o[d][r] *= al_l[crow(r, hi)]; } } while (0)
  f32x16 pA0, pA1, pB0, pB1; float mnA, mnB, alA, alB; bf16x8 pa0, pa1, pa2, pa3; const int NT = seq / 64;
  SLOAD0(0); asm volatile("s_waitcnt vmcnt(0)" ::: "memory"); SWRITE0(0); __syncthreads();
  qkt(pA0, pA1, K_lds, qr, r32, hi); partialSM(pA0, pA1, m_reg, mnA, alA);
  SLOAD1(64); if (2 < NT) SLOAD0(2 * 64);
  SWAIT(); SWRITE1(1); __syncthreads();
  for (int j = 1; j + 1 < NT; j += 2) {
    SBAR(); qkt(pB0, pB1, K_lds + SHM_K, qr, r32, hi);
    finishSM(pA0, pA1, alA, l_reg, pa0, pa1, pa2, pa3); SBAR();
    SLOAD1((j + 2) * 64); SBAR();
    pv_d0(o, vb0, pa0, pa1, pa2, pa3); partialSM(pB0, pB1, m_reg, mnB, alB);
    __syncthreads(); SWAIT(); SWRITE0(0);
    RESC(alB); __syncthreads();
    SBAR(); qkt(pA0, pA1, K_lds, qr, r32, hi);
    finishSM(pB0, pB1, alB, l_reg, pa0, pa1, pa2, pa3); SBAR();
    if (j + 3 < NT) SLOAD0((j + 3) * 64); SBAR();
    pv_d0(o, vb0 + SHM_V, pa0, pa1, pa2, pa3); partialSM(pA0, pA1, m_reg, mnA, alA);
    __syncthreads(); SWAIT(); SWRITE1(1);
    RESC(alA); __syncthreads();
  }
  SBAR(); qkt(pB0, pB1, K_lds + SHM_K, qr, r32, hi);
  finishSM(pA0, pA1, alA, l_reg, pa0, pa1, pa2, pa3); SBAR();
  pv_d0(o, vb0, pa0, pa1, pa2, pa3); partialSM(pB0, pB1, m_reg, mnB, alB);
  __syncthreads(); RESC(alB);
  finishSM(pB0, pB1, alB, l_reg, pa0, pa1, pa2, pa3); SBAR();
  pv_d0(o, vb0 + SHM_V, pa0, pa1, pa2, pa3);
  if (hi == 0) li_l[r32] = l_reg; asm volatile("s_waitcnt lgkmcnt(0)" ::: "memory");
  u16* Ow = Ob + (long)(wid * 32) * 1024;
#pragma unroll
  for (int r = 0; r < 16; ++r) { const int orow = crow(r, hi); const float rl = __builtin_amdgcn_rcpf(li_l[orow]);
#pragma unroll
    for (int d0 = 0; d0 < 2; ++d0) Ow[(long)orow * 1024 + d0 * 32 + r32] = f2bf(o[d0][r] * rl); }
#undef SLOAD0
#undef SLOAD1
#undef SWRITE0
#undef SWRITE1
#undef SWAIT
#undef RESC
}

__device__ __forceinline__ void phase_attn(const Params& p_unused_, char* lds) {
  PHASE_PARAMS;
  char* wsb = p.ws; asm volatile("" : "+s"(wsb));
  const u16* q = (const u16*)(wsb + B_Q);
  const u16* kv = (const u16*)(wsb + B_KV);
  const u16* kr = (const u16*)(wsb + B_KR);
  u16* mix = (u16*)(wsb + OFF_C);
  for (int u = blockIdx.x; u < 1280; u += gridDim.x) {
    size_t m0, kvrow0; int h, seq;
    if (u < 1024) {
      const int it = u >> 8, i = u & 255, xcd = i & 7, j = i >> 3;
      const int bh = it * 16 + xcd * 2 + (j >> 4), qb = j & 15, b = bh >> 3;
      h = bh & 7; m0 = (size_t)M_CTX + (size_t)b * S_LAT + qb * 256; kvrow0 = (size_t)M_CTX + (size_t)b * T_LAT; seq = T_LAT;
    } else {
      const int uu = u - 1024, b = uu >> 3; h = uu & 7; m0 = (size_t)b * 256; kvrow0 = m0; seq = S_CTX;
    }
    __syncthreads();
    attn_body(q + m0 * 768 + h * 96, kv + kvrow0 * 1024 + h * 128, kr + kvrow0 * 32, kv + kvrow0 * 1024 + h * 128 + 64, mix + m0 * 1024 + h * 64, seq, lds);
  }
}


#define XB_TMO      128
#define XB_XCNT(j)  (256  + 64 * (j))
#define XB_XSUB(j)  (1280 + 64 * (j))
#define XB_XGEN(j)  (2304 + 64 * (j))
#define XB_TOP      3328
#define XB_TOPGEN   3392
#define XCD_BAR_WORDS 3456
#define XB_SPIN_CAP (1u << 18)
#define LAS __attribute__((address_space(3)))
__device__ __forceinline__ unsigned xb_ld(unsigned* p)              { return __hip_atomic_load(p, __ATOMIC_RELAXED, __HIP_MEMORY_SCOPE_AGENT); }
__device__ __forceinline__ unsigned xb_add(unsigned* p, unsigned v) { return __hip_atomic_fetch_add(p, v, __ATOMIC_RELAXED, __HIP_MEMORY_SCOPE_AGENT); }
__device__ __forceinline__ unsigned xb_xcc_id() { return (unsigned)__builtin_amdgcn_s_getreg((3 << 11) | 20) & 0xFu; }
#define XB_SPIN(cond, bar) do { unsigned _sp = 0; while (cond) { __builtin_amdgcn_s_sleep(1); \
    if ((++_sp & 255u) == 0u) { if (xb_ld(&(bar)[XB_TMO])) break; if (_sp > XB_SPIN_CAP) { atomicAdd(&(bar)[XB_TMO], 1u); break; } } } } while (0)
struct XcdBarrier { unsigned* bar; unsigned x; volatile LAS unsigned* st; };
__device__ __forceinline__ XcdBarrier xcd_barrier_post(unsigned* bar, volatile LAS unsigned* st) {
  XcdBarrier b; b.bar = bar; b.x = (unsigned)__builtin_amdgcn_readfirstlane((int)xb_xcc_id()); b.st = st;
  if (threadIdx.x == 0) (void)xb_add(&bar[XB_XCNT(b.x)], 1u);
  return b;
}
__device__ __forceinline__ void xcd_barrier_complete(unsigned* bar, unsigned x, unsigned& nloc, unsigned& nx) {
  const unsigned G = gridDim.x * gridDim.y * gridDim.z;
  unsigned sum, cnt, mine, sp = 0u;
  for (;;) {
    sum = 0u; cnt = 0u; mine = 0u;
#pragma unroll
    for (unsigned j = 0; j < 16; ++j) { const unsigned c = xb_ld(&bar[XB_XCNT(j)]); sum += c; cnt += (c > 0u) ? 1u : 0u; mine = (j == x) ? c : mine; }
    if (sum == G) break;
    __builtin_amdgcn_s_sleep(1);
    if ((++sp & 255u) == 0u) { if (xb_ld(&bar[XB_TMO])) break; if (sp > XB_SPIN_CAP) { atomicAdd(&bar[XB_TMO], 1u); break; } }
  }
  nloc = mine > 0u ? mine : 1u; nx = cnt > 0u ? cnt : 1u;
}
__device__ __forceinline__ void xcd_barrier(const XcdBarrier& b) {
  asm volatile("s_waitcnt vmcnt(0)" ::: "memory");
  __syncthreads();
  if (threadIdx.x == 0) {
    unsigned* bar = b.bar; asm volatile("" : "+s"(bar));
    unsigned bx = b.x; asm volatile("" : "+s"(bx));
    __builtin_amdgcn_s_waitcnt(0);
    unsigned nloc = b.st[0], nx = b.st[1];
    if (nloc == 0u) { xcd_barrier_complete(bar, bx, nloc, nx); b.st[0] = nloc; b.st[1] = nx; }
    const unsigned old = xb_add(&bar[XB_XSUB(bx)], 1u);
    const unsigned gen = old / nloc;
    if (old + 1u == (gen + 1u) * nloc) {
      __builtin_amdgcn_fence(__ATOMIC_RELEASE, "agent");
      asm volatile("s_waitcnt vmcnt(0)" ::: "memory");
      const unsigned og = xb_add(&bar[XB_TOP], 1u);
      const unsigned tg = og / nx;
      if (og + 1u == (tg + 1u) * nx) xb_add(&bar[XB_TOPGEN], 1u);
      else XB_SPIN(xb_ld(&bar[XB_TOPGEN]) == tg, bar);
      __builtin_amdgcn_fence(__ATOMIC_ACQUIRE, "agent");
      xb_add(&bar[XB_XGEN(bx)], 1u);
      asm volatile("s_waitcnt vmcnt(0)" ::: "memory");
    } else {
      XB_SPIN(xb_ld(&bar[XB_XGEN(bx)]) == gen, bar);
      __builtin_amdgcn_fence(__ATOMIC_ACQUIRE, "agent");
      asm volatile("s_waitcnt vmcnt(0)" ::: "memory");
    }
  }
  __syncthreads();
}
#define GSYNC() xcd_barrier(xb)

#ifndef STOP_AT
#define STOP_AT 0
#endif
__device__ __forceinline__ void phase_dump(const Params& p, const u16* buf, size_t count, int isf32) {
  const size_t n = 44564480;
  for (size_t i = (size_t)blockIdx.x * NTHR + threadIdx.x; i < n; i += (size_t)gridDim.x * NTHR) {
    float v = 0.f;
    if (i < count) v = isf32 ? ((const float*)buf)[i] : bf2f(buf[i]);
    if (!(fabsf(v) < 1e30f)) v = 7777.f;
    p.out[i] = v;
  }
}
#define STOP(k, buf, count, isf32) do { if (STOP_AT == (k)) { GSYNC(); phase_dump(p, (const u16*)(buf), (count), (isf32)); return; } } while (0)
__global__ void __launch_bounds__(NTHR) fwd_megakernel(Params p) {
  extern __shared__ __attribute__((aligned(16))) char lds[];
  cg::grid_group grid = cg::this_grid();
  if (p.out == nullptr) grid.sync();
  volatile LAS unsigned* xst = (volatile LAS unsigned*)(lds + LDS_MAIN);
  if (threadIdx.x == 0) { xst[0] = 0u; xst[1] = 0u; }
  __syncthreads();
  XcdBarrier xb = xcd_barrier_post((unsigned*)(p.ws + OFF_BAR), xst);
  phase_prep(p, lds);
  STOP(1, p.ws + OFF_W, (OFF_TAB + 4096) / 2, 0);
  GSYNC();
  phase_rows(p, 0, 0);
  STOP(2, p.ws + OFF_C, (size_t)M_TOK * 1024, 0);
  GSYNC();
  for (int lv = 0; lv < DEPTH; ++lv) {
    int l = lv; asm volatile("" : "+s"(l));
    phase_gemm_in(p, l, lds);
    STOP(3, p.ws + A_PROJ, (size_t)M_TOK * IN_COLS, 0);
    GSYNC();
    phase_mid(p, l, lds);
    STOP(4, p.ws + A_QAN, (A_END - A_QAN) / 2, 0);
    GSYNC();
    phase_gemm_mix(p, l, lds);
    STOP(5, p.ws + B_Q, (B_END - B_Q) / 2, 0);
    GSYNC();
    phase_attn(p, lds);
    STOP(6, p.ws + OFF_C, (size_t)M_TOK * 1024, 0);
    GSYNC();
    phase_gemm_f32out(p, OFF_C, 1024, OFF_W + (size_t)l * WL_SIZE + WL_OUT, lds);
    STOP(7, p.ws + OFF_B, (size_t)M_TOK * 1024, 1);
    GSYNC();
    phase_rows(p, 1, l);
    STOP(8, p.ws + OFF_C, (size_t)M_TOK * 1024, 0);
    GSYNC();
    phase_gemm_up(p, l, lds);
    STOP(9, p.ws + OFF_A, (size_t)M_TOK * DFF, 0);
    GSYNC();
    phase_fixup(p, l);
    STOP(10, p.ws + OFF_A, (size_t)M_TOK * DFF, 0);
    GSYNC();
    phase_gemm_f32out(p, OFF_A, DFF, OFF_W + (size_t)l * WL_SIZE + WL_DOWN, lds);
    STOP(11, p.ws + OFF_B, (size_t)M_TOK * 1024, 1);
    GSYNC();
    phase_rows(p, 2, l);
    if (l + 1 < DEPTH) GSYNC();
  }
}

extern "C" void kernel_launch(void* const* d_in, const int* in_sizes, int n_in, void* d_out, int out_size, void* d_ws, size_t ws_size,
                              hipStream_t stream) {
  static int grid_blocks = 0;
  if (!grid_blocks) {
    if (n_in != 27 || ws_size < WS_END) { fprintf(stderr, "kernel_launch: bad n_in %d or ws_size %zu < %zu\n", n_in, ws_size, (size_t)WS_END); return; }
    if (hipFuncSetAttribute((const void*)fwd_megakernel, hipFuncAttributeMaxDynamicSharedMemorySize, LDS_BYTES) != hipSuccess) {
      fprintf(stderr, "kernel_launch: hipFuncSetAttribute failed\n"); return; }
    int dev = 0, cus = 0, per_cu = 0;
    hipGetDevice(&dev);
    hipDeviceGetAttribute(&cus, hipDeviceAttributeMultiprocessorCount, dev);
    hipOccupancyMaxActiveBlocksPerMultiprocessor(&per_cu, fwd_megakernel, NTHR, LDS_BYTES);
    if (per_cu < 1) { fprintf(stderr, "kernel_launch: occupancy 0\n"); return; }
    grid_blocks = cus;
  }
  Params p{};
  const float** pp = (const float**)&p;
  for (int i = 0; i < 27; ++i) pp[i] = (const float*)d_in[i];
  p.out = (float*)d_out;
  p.ws = (char*)d_ws;
  hipMemsetAsync((char*)d_ws + OFF_BAR, 0, XCD_BAR_WORDS * 4, stream);
  void* args[] = {&p};
  hipError_t e = hipLaunchCooperativeKernel((void*)fwd_megakernel, dim3(grid_blocks), dim3(NTHR), args, LDS_BYTES, stream);
  if (e != hipSuccess) fprintf(stderr, "cooperative launch failed: %s (grid %d)\n", hipGetErrorString(e), grid_blocks);
}
```

```cpp
#include <hip/hip_runtime.h>
#include <hip/hip_cooperative_groups.h>
#include <cstdio>
#include <cstdint>
namespace cg = cooperative_groups;

typedef unsigned short u16;
using bf16x8 = __attribute__((ext_vector_type(8))) short;
using s16x4  = __attribute__((ext_vector_type(4))) short;
using f32x16 = __attribute__((ext_vector_type(16))) float;
using u32x4  = __attribute__((ext_vector_type(4))) unsigned;
using u32x2  = __attribute__((ext_vector_type(2))) unsigned;

constexpr int DM = 1024, DEPTH = 2;
constexpr int M_CTX = 8192, M_LAT = 32768, M_TOK = 40960;
constexpr int S_CTX = 256, S_LAT = 4096, PAST = 512, T_LAT = 4608;
constexpr int KV_ROWS = M_CTX + 8 * T_LAT;
constexpr int IN_COLS = 1184, IN_PAD = 1280;
constexpr int DFF = 2816;
constexpr float EPS = 1e-6f;
constexpr int NTHR = 512;

constexpr size_t WL_IN = 0;
constexpr size_t WL_QB = WL_IN + (size_t)IN_PAD * 1024 * 2;
constexpr size_t WL_KVB = WL_QB + (size_t)768 * 256 * 2;
constexpr size_t WL_POOL = WL_KVB + (size_t)1024 * 128 * 2;
constexpr size_t WL_SGU = WL_POOL + (size_t)256 * 256 * 2;
constexpr size_t WL_OUT = WL_SGU + (size_t)4 * 128 * 128 * 2;
constexpr size_t WL_UP = WL_OUT + (size_t)1024 * 1024 * 2;
constexpr size_t WL_DOWN = WL_UP + (size_t)5632 * 1024 * 2;
constexpr size_t WL_SIZE = WL_DOWN + (size_t)1024 * 2816 * 2;
constexpr size_t OFF_W = 0;
constexpr size_t OFF_MOD = OFF_W + 2 * WL_SIZE;
constexpr size_t OFF_TAB = OFF_MOD + (size_t)2 * 9 * 6144 * 4;
constexpr size_t OFF_BAR = OFF_TAB + 4096;
constexpr size_t OFF_C = OFF_BAR + 16384;
constexpr size_t OFF_A = OFF_C + (size_t)M_TOK * 1024 * 2;
constexpr size_t A_PROJ = OFF_A;
constexpr size_t A_QAN = A_PROJ + (size_t)M_TOK * IN_COLS * 2;
constexpr size_t A_CKV = A_QAN + (size_t)M_TOK * 256 * 2;
constexpr size_t A_DPOOL = A_CKV + (size_t)KV_ROWS * 128 * 2;
constexpr size_t A_VT = A_DPOOL + (size_t)M_TOK * 256 * 2;
constexpr size_t A_END = A_VT + (size_t)M_TOK * 256 * 2;
constexpr size_t OFF_B = OFF_A + (size_t)M_TOK * DFF * 2;
static_assert(A_END <= OFF_B, "region A overflow");
constexpr size_t B_Q = OFF_B;
constexpr size_t B_KV = B_Q + (size_t)M_TOK * 768 * 2;
constexpr size_t B_KR = B_KV + (size_t)KV_ROWS * 1024 * 2;
constexpr size_t B_END = B_KR + (size_t)KV_ROWS * 32 * 2;
constexpr size_t WS_END = OFF_B + (size_t)M_TOK * 1024 * 4;
static_assert(B_END <= WS_END, "region B overflow");

constexpr size_t OUT_CKV = (size_t)M_TOK * 1024;
constexpr size_t OUT_KR = OUT_CKV + (size_t)32 * 2 * 256 * 128;

constexpr int LDS_MAIN = 135168;
constexpr int LDS_BYTES = LDS_MAIN + 16;

struct Params {
  const float *x_prompt, *x_sample, *cache_ckv, *cache_krope, *c, *c_ctx, *w_mod, *b_mod,
      *g_pre_mix, *g_post_mix, *g_pre_ffn, *g_post_ffn, *w_in, *g_q_a, *w_q_b, *g_kv_a, *w_kv_b,
      *w_pool, *pool_scale, *g_sgu, *w_sgu, *b_sgu, *w_out, *w_up, *conv_w, *conv_b, *w_down;
  float* out;
  char* ws;
};

typedef float f32x2_t __attribute__((ext_vector_type(2)));
typedef __bf16 bf16x2_t __attribute__((ext_vector_type(2)));
__device__ __forceinline__ unsigned cvtpk(float lo, float hi) {
  f32x2_t v = {lo, hi};
  bf16x2_t r = __builtin_convertvector(v, bf16x2_t);
  return __builtin_bit_cast(unsigned, r);
}
__device__ __forceinline__ u16 f2bf(float x) { return (u16)(cvtpk(x, 0.f) & 0xffffu); }
__device__ __forceinline__ float bf2f(u16 b) { return __uint_as_float(((unsigned)b) << 16); }
__device__ __forceinline__ float bflo(unsigned w) { return __uint_as_float(w << 16); }
__device__ __forceinline__ float bfhi(unsigned w) { return __uint_as_float(w & 0xffff0000u); }
__device__ __forceinline__ float wave_sum(float v) {
  v += __int_as_float(__builtin_amdgcn_mov_dpp(__float_as_int(v), 0xB1, 0xF, 0xF, true));
  v += __int_as_float(__builtin_amdgcn_mov_dpp(__float_as_int(v), 0x4E, 0xF, 0xF, true));
  v += __int_as_float(__builtin_amdgcn_mov_dpp(__float_as_int(v), 0x124, 0xF, 0xF, true));
  v += __int_as_float(__builtin_amdgcn_mov_dpp(__float_as_int(v), 0x128, 0xF, 0xF, true));
  v += __shfl_xor(v, 16);
  v += __shfl_xor(v, 32);
  return v;
}
__device__ __forceinline__ int opaque_tid() { int t = threadIdx.x; asm volatile("" : "+v"(t)); return t; }
__device__ __forceinline__ int crow(int r, int hi) { return (r & 3) + 8 * (r >> 2) + 4 * hi; }
__device__ __forceinline__ float silu_f(float x) { return x * __builtin_amdgcn_rcpf(1.f + __builtin_amdgcn_exp2f(-1.4426950408889634f * x)); }

#define KARG __attribute__((address_space(4)))
#define PHASE_PARAMS const KARG char* kp_ = (const KARG char*)__builtin_amdgcn_kernarg_segment_ptr(); asm volatile("" : "+s"(kp_)); Params p; \
  p.x_prompt = *(const float* const KARG*)(kp_ + 0); \
  p.x_sample = *(const float* const KARG*)(kp_ + 8); \
  p.cache_ckv = *(const float* const KARG*)(kp_ + 16); \
  p.cache_krope = *(const float* const KARG*)(kp_ + 24); \
  p.c = *(const float* const KARG*)(kp_ + 32); \
  p.c_ctx = *(const float* const KARG*)(kp_ + 40); \
  p.w_mod = *(const float* const KARG*)(kp_ + 48); \
  p.b_mod = *(const float* const KARG*)(kp_ + 56); \
  p.g_pre_mix = *(const float* const KARG*)(kp_ + 64); \
  p.g_post_mix = *(const float* const KARG*)(kp_ + 72); \
  p.g_pre_ffn = *(const float* const KARG*)(kp_ + 80); \
  p.g_post_ffn = *(const float* const KARG*)(kp_ + 88); \
  p.w_in = *(const float* const KARG*)(kp_ + 96); \
  p.g_q_a = *(const float* const KARG*)(kp_ + 104); \
  p.w_q_b = *(const float* const KARG*)(kp_ + 112); \
  p.g_kv_a = *(const float* const KARG*)(kp_ + 120); \
  p.w_kv_b = *(const float* const KARG*)(kp_ + 128); \
  p.w_pool = *(const float* const KARG*)(kp_ + 136); \
  p.pool_scale = *(const float* const KARG*)(kp_ + 144); \
  p.g_sgu = *(const float* const KARG*)(kp_ + 152); \
  p.w_sgu = *(const float* const KARG*)(kp_ + 160); \
  p.b_sgu = *(const float* const KARG*)(kp_ + 168); \
  p.w_out = *(const float* const KARG*)(kp_ + 176); \
  p.w_up = *(const float* const KARG*)(kp_ + 184); \
  p.conv_w = *(const float* const KARG*)(kp_ + 192); \
  p.conv_b = *(const float* const KARG*)(kp_ + 200); \
  p.w_down = *(const float* const KARG*)(kp_ + 208); \
  p.out = *(float* const KARG*)(kp_ + 216); p.ws = *(char* const KARG*)(kp_ + 224)
__device__ __forceinline__ void cvt_tile_T(const float* __restrict__ src, int ld_src, u16* __restrict__ dst, int K, int kt, int nt, int mode,
                           int Nvalid, float* t) {
  const int tid = opaque_tid();
  const int k0 = kt * 64, n0 = nt * 128;
  {
    const int n = n0 + (tid & 127);
    int sc; bool valid;
    if (mode == 1) { const int t256 = n >> 8, wn = (n >> 6) & 3, blk = (n >> 5) & 1, c = n & 31; sc = blk * DFF + t256 * 128 + wn * 32 + c; valid = true; }
    else { sc = n; valid = n < Nvalid; }
    float v[16];
#pragma unroll
    for (int i = 0; i < 16; ++i) { const int k = (tid >> 7) + 4 * i; v[i] = valid ? src[(long)(k0 + k) * ld_src + sc] : 0.f; }
#pragma unroll
    for (int i = 0; i < 16; ++i) { const int k = (tid >> 7) + 4 * i; t[k * 129 + (tid & 127)] = v[i]; }
  }
  __syncthreads();
  {
    const int n = tid >> 2, kc = tid & 3;
    float v[16];
#pragma unroll
    for (int j = 0; j < 16; ++j) v[j] = t[(kc * 16 + j) * 129 + n];
    u32x4 w0 = {cvtpk(v[0], v[1]), cvtpk(v[2], v[3]), cvtpk(v[4], v[5]), cvtpk(v[6], v[7])};
    u32x4 w1 = {cvtpk(v[8], v[9]), cvtpk(v[10], v[11]), cvtpk(v[12], v[13]), cvtpk(v[14], v[15])};
    u16* d = dst + (long)(n0 + n) * K + k0 + kc * 16;
    *(u32x4*)d = w0; *(u32x4*)(d + 8) = w1;
  }
  __syncthreads();
}

__device__ __forceinline__ void mod_job(const Params& p, int l, int nt64, float* lds) {
  char* wsb = p.ws; asm volatile("" : "+s"(wsb));
  const int tid = opaque_tid();
  float* sc = lds; float* red = lds + 9216;
  for (int idx = tid; idx < 9216; idx += NTHR) {
    const int r = idx >> 10, k = idx & 1023;
    const float x = (r == 0) ? p.c_ctx[k] : p.c[(r - 1) * 1024 + k];
    sc[idx] = x / (1.f + expf(-x));
  }
  __syncthreads();
  const int kq = tid >> 6, cc = tid & 63, n = nt64 * 64 + cc;
  float acc[9];
#pragma unroll
  for (int r = 0; r < 9; ++r) acc[r] = 0.f;
  const float* wp = p.w_mod + ((long)l * 1024 + kq * 128) * 6144 + n;
#pragma unroll 32
  for (int kk = 0; kk < 128; ++kk) {
    const float w = wp[(long)kk * 6144];
    const int k = kq * 128 + kk;
#pragma unroll
    for (int r = 0; r < 9; ++r) acc[r] = fmaf(sc[r * 1024 + k], w, acc[r]);
  }
#pragma unroll
  for (int r = 0; r < 9; ++r) red[(kq * 9 + r) * 64 + cc] = acc[r];
  __syncthreads();
  float* mod = (float*)(wsb + OFF_MOD);
  for (int idx = tid; idx < 576; idx += NTHR) {
    const int r = idx >> 6, c2 = idx & 63, n2 = nt64 * 64 + c2;
    float s = p.b_mod[l * 6144 + n2];
#pragma unroll
    for (int q = 0; q < 8; ++q) s += red[(q * 9 + r) * 64 + c2];
    mod[(l * 9 + r) * 6144 + n2] = s;
  }
  __syncthreads();
}

__device__ __forceinline__ void phase_prep(const Params& p_unused_, char* lds) {
  PHASE_PARAMS;
  char* wsb = p.ws; asm volatile("" : "+s"(wsb));
  const int tid = opaque_tid();
  constexpr int PER_L = 1416;
  constexpr int NJOBS = 193 + 2 * PER_L;
  for (int job = blockIdx.x; job < NJOBS; job += gridDim.x) {
    if (job < 192) { mod_job(p, job / 96, job % 96, (float*)lds); continue; }
    if (job == 192) {
      float2* tab = (float2*)(wsb + OFF_TAB);
      const int pos = tid >> 3, f = tid & 7;
      const float freq = powf(10000.f, -(float)f / 8.f);
      const float ang = (float)pos * freq;
      tab[tid] = make_float2(cosf(ang), sinf(ang));
      continue;
    }
    int j = job - 193; const int l = j / PER_L; j -= l * PER_L;
    char* wl = wsb + OFF_W + (size_t)l * WL_SIZE;
    float* t = (float*)lds;
    if (j < 160) { cvt_tile_T(p.w_in + (size_t)l * 1024 * IN_COLS, IN_COLS, (u16*)(wl + WL_IN), 1024, j / 10, j % 10, 0, IN_COLS, t); continue; }
    j -= 160;
    if (j < 24) { cvt_tile_T(p.w_q_b + (size_t)l * 256 * 768, 768, (u16*)(wl + WL_QB), 256, j / 6, j % 6, 0, 768, t); continue; }
    j -= 24;
    if (j < 16) { cvt_tile_T(p.w_kv_b + (size_t)l * 128 * 1024, 1024, (u16*)(wl + WL_KVB), 128, j / 8, j % 8, 0, 1024, t); continue; }
    j -= 16;
    if (j < 128) { cvt_tile_T(p.w_out + (size_t)l * 1024 * 1024, 1024, (u16*)(wl + WL_OUT), 1024, j / 8, j % 8, 0, 1024, t); continue; }
    j -= 128;
    if (j < 704) { cvt_tile_T(p.w_up + (size_t)l * 1024 * 5632, 5632, (u16*)(wl + WL_UP), 1024, j / 44, j % 44, 1, 5632, t); continue; }
    j -= 704;
    if (j < 352) { cvt_tile_T(p.w_down + (size_t)l * 2816 * 1024, 1024, (u16*)(wl + WL_DOWN), 2816, j / 8, j % 8, 0, 1024, t); continue; }
    j -= 352;
    if (j < 16) {
      u16* dst = (u16*)(wl + WL_POOL);
      for (int i = 0; i < 8; ++i) {
        const int idx = j * 4096 + i * 512 + tid; const int n = idx >> 8, k = idx & 255;
        const int g = n >> 6, e = n & 63, g2 = k >> 6, c = k & 63;
        dst[idx] = (g == g2) ? f2bf(p.w_pool[(((size_t)l * 4 + g) * 64 + c) * 64 + e]) : (u16)0;
      }
      continue;
    }
    j -= 16;
    {
      u16* dst = (u16*)(wl + WL_SGU);
      for (int i = 0; i < 8; ++i) { const int idx = j * 4096 + i * 512 + tid; dst[idx] = f2bf(p.w_sgu[(size_t)l * 65536 + idx]); }
    }
  }
}

__device__ __forceinline__ void phase_rows(const Params& p_unused_, int mode, int l) {
  PHASE_PARAMS;
  char* wsb = p.ws; asm volatile("" : "+s"(wsb));
  const int tid = opaque_tid(), wid = tid >> 6, lane = tid & 63;
  const float* mod = (const float*)(wsb + OFF_MOD);
  const u16* obuf = (const u16*)(wsb + OFF_B);
  u16* hbuf = (u16*)(wsb + OFF_C);
  u16* x1buf = (u16*)(wsb + OFF_B + (size_t)M_TOK * 1024 * 2);
  u16* x2buf = (u16*)p.out;
  const bool from_in = (mode == 0 || (mode == 1 && l == 0));
  const bool final_out = (mode == 2 && l + 1 >= DEPTH);
  const u16* xsrc = (mode == 1) ? x2buf : x1buf;
  u16* xdst = (mode == 1) ? x1buf : x2buf;
  const int stride = gridDim.x * 8;
  float4 xn[2][4]; u32x2 xbn[2][4]; u32x2 on[2][4];
#define ROW_LOAD(k, mm) do { const int m_ = (mm); \
    if (from_in) { const float* xs_ = (m_ < M_CTX) ? p.x_prompt + (size_t)m_ * 1024 : p.x_sample + (size_t)(m_ - M_CTX) * 1024; \
      _Pragma("unroll") for (int i = 0; i < 4; ++i) xn[k][i] = *(const float4*)(xs_ + i * 256 + lane * 4); } \
    else { _Pragma("unroll") for (int i = 0; i < 4; ++i) xbn[k][i] = *(const u32x2*)(xsrc + (size_t)m_ * 1024 + i * 256 + lane * 4); } \
    if (mode != 0) { _Pragma("unroll") for (int i = 0; i < 4; ++i) on[k][i] = *(const u32x2*)(obuf + (size_t)m_ * 1024 + i * 256 + lane * 4); } } while (0)
  const int per = (((M_TOK + stride - 1) / stride) + 1) & ~1;
  int m = (blockIdx.x * 8 + wid) * per;
  const int mend = min(m + per, M_TOK);
  if (m < mend) { ROW_LOAD(0, m); ROW_LOAD(1, m + 1); }
  const int step = 2;
  const int nk = 2;
  const int lh_ = (mode == 2) ? l + 1 : l;
  float4 c_gp[4], c_gpre[4], c_gate[4], c_shift[4], c_scale[4];
  {
    const float* gp_ = ((mode == 1) ? p.g_post_mix : p.g_post_ffn) + l * 1024;
    const float* gpre_ = ((mode == 1) ? p.g_pre_ffn : p.g_pre_mix) + (final_out ? l : lh_) * 1024;
#pragma unroll
    for (int i = 0; i < 4; ++i) { c_gp[i] = *(const float4*)(gp_ + i * 256 + lane * 4); c_gpre[i] = *(const float4*)(gpre_ + i * 256 + lane * 4); }
  }
  int rcur = -1;
  for (; m < mend; m += step) {
    {
      const int rnew = (m < M_CTX) ? 0 : 1 + ((m - M_CTX) >> 12);
      if (rnew != rcur) {
        rcur = rnew;
        const float* gate_ = mod + ((size_t)l * 9 + rnew) * 6144 + ((mode == 1) ? 2 : 5) * 1024;
        const float* modh_ = mod + ((size_t)(final_out ? l : lh_) * 9 + rnew) * 6144;
        const float* shift_ = modh_ + ((mode == 1) ? 3 : 0) * 1024;
        const float* scale_ = modh_ + ((mode == 1) ? 4 : 1) * 1024;
#pragma unroll
        for (int i = 0; i < 4; ++i) {
          c_gate[i] = *(const float4*)(gate_ + i * 256 + lane * 4);
          c_shift[i] = *(const float4*)(shift_ + i * 256 + lane * 4);
          c_scale[i] = *(const float4*)(scale_ + i * 256 + lane * 4);
        }
      }
    }
    float4 x[2][4]; u32x2 ow[2][4];
#pragma unroll
    for (int k = 0; k < 2; ++k)
#pragma unroll
      for (int i = 0; i < 4; ++i) {
        x[k][i] = from_in ? xn[k][i] : make_float4(bflo(xbn[k][i][0]), bfhi(xbn[k][i][0]), bflo(xbn[k][i][1]), bfhi(xbn[k][i][1]));
        ow[k][i] = on[k][i];
      }
    if (m + step < mend) { ROW_LOAD(0, m + step); ROW_LOAD(1, m + step + 1); }
    float rstd_o[2], rstd_x[2];
    int rr[2];
#pragma unroll
    for (int k = 0; k < 2; ++k) { const int mk = m + k; rr[k] = (mk < M_CTX) ? 0 : 1 + ((mk - M_CTX) >> 12); }
    if (mode != 0) {
      float ss[2];
#pragma unroll
      for (int k = 0; k < 2; ++k) {
        ss[k] = 0.f;
#pragma unroll
        for (int i = 0; i < 4; ++i) { const float a = bflo(ow[k][i][0]), b = bfhi(ow[k][i][0]), c = bflo(ow[k][i][1]), d = bfhi(ow[k][i][1]); ss[k] += a * a + b * b + c * c + d * d; }
      }
      ss[0] = wave_sum(ss[0]); ss[1] = wave_sum(ss[1]);
      rstd_o[0] = rsqrtf(ss[0] * (1.f / 1024.f) + EPS); rstd_o[1] = rsqrtf(ss[1] * (1.f / 1024.f) + EPS);
      const float* gp = ((mode == 1) ? p.g_post_mix : p.g_post_ffn) + l * 1024;
#pragma unroll
      for (int k = 0; k < 2; ++k) {
        if (k >= nk) break;
        const int mk = m + k;
        const float* gate = mod + ((size_t)l * 9 + rr[k]) * 6144 + ((mode == 1) ? 2 : 5) * 1024;
#pragma unroll
        for (int i = 0; i < 4; ++i) {
          const int c = i * 256 + lane * 4;
          const float4 g = c_gp[i], gt = c_gate[i];
          x[k][i].x += gt.x * (bflo(ow[k][i][0]) * rstd_o[k] * g.x); x[k][i].y += gt.y * (bfhi(ow[k][i][0]) * rstd_o[k] * g.y);
          x[k][i].z += gt.z * (bflo(ow[k][i][1]) * rstd_o[k] * g.z); x[k][i].w += gt.w * (bfhi(ow[k][i][1]) * rstd_o[k] * g.w);
          if (final_out) *(float4*)(p.out + (size_t)mk * 1024 + c) = x[k][i];
          else { u32x2 w = {cvtpk(x[k][i].x, x[k][i].y), cvtpk(x[k][i].z, x[k][i].w)}; *(u32x2*)(xdst + (size_t)mk * 1024 + c) = w; }
        }
      }
    }
    if (final_out) continue;
    const int lh = (mode == 2) ? l + 1 : l;
    const float* gpre = ((mode == 1) ? p.g_pre_ffn : p.g_pre_mix) + lh * 1024;
    {
      float ss[2];
#pragma unroll
      for (int k = 0; k < 2; ++k) {
        ss[k] = 0.f;
#pragma unroll
        for (int i = 0; i < 4; ++i) ss[k] += x[k][i].x * x[k][i].x + x[k][i].y * x[k][i].y + x[k][i].z * x[k][i].z + x[k][i].w * x[k][i].w;
      }
      ss[0] = wave_sum(ss[0]); ss[1] = wave_sum(ss[1]);
      rstd_x[0] = rsqrtf(ss[0] * (1.f / 1024.f) + EPS); rstd_x[1] = rsqrtf(ss[1] * (1.f / 1024.f) + EPS);
    }
#pragma unroll
    for (int k = 0; k < 2; ++k) {
      if (k >= nk) break;
      const int mk = m + k;
      const float* modh = mod + ((size_t)lh * 9 + rr[k]) * 6144;
      const float* shift = modh + ((mode == 1) ? 3 : 0) * 1024;
      const float* scale = modh + ((mode == 1) ? 4 : 1) * 1024;
#pragma unroll
      for (int i = 0; i < 4; ++i) {
        const int c = i * 256 + lane * 4;
        const float4 g = c_gpre[i], sh = c_shift[i], sc = c_scale[i];
        const float h0 = x[k][i].x * rstd_x[k] * g.x * (1.f + sc.x) + sh.x, h1 = x[k][i].y * rstd_x[k] * g.y * (1.f + sc.y) + sh.y;
        const float h2 = x[k][i].z * rstd_x[k] * g.z * (1.f + sc.z) + sh.z, h3 = x[k][i].w * rstd_x[k] * g.w * (1.f + sc.w) + sh.w;
        u32x2 w = {cvtpk(h0, h1), cvtpk(h2, h3)};
        *(u32x2*)(hbuf + (size_t)mk * 1024 + c) = w;
      }
    }
  }
#undef ROW_LOAD
}

__device__ __forceinline__ void gemm_mainloop(const u16* __restrict__ A, int lda, const u16* __restrict__ Bt, int ldb, int K, char* lds,
                                              f32x16 (&acc)[2][2], const int tid) {
  const int wid = tid >> 6, lane = tid & 63, r32 = lane & 31, hi = lane >> 5, wm = wid >> 1, wn = wid & 1;
  const int lrow = tid >> 3, lch = tid & 7;
  const u16* ag = A + (long)lrow * lda + lch * 8;
  const u16* bg = Bt + (long)lrow * ldb + lch * 8;
  const int woff = lrow * 128 + ((lch ^ ((lrow >> 1) & 7)) << 4);
  const int arow = wm * 64 + r32, asw = (arow >> 1) & 7;
  const int brow = wn * 64 + r32, bsw = (brow >> 1) & 7;
  u32x4 ra0[4], rb0[2], ra1[4], rb1[2];
#define GLOAD(kt, RA, RB) do { _Pragma("unroll") for (int i = 0; i < 4; ++i) RA[i] = *(const u32x4*)(ag + (long)(64 * i) * lda + (kt) * 64); \
    _Pragma("unroll") for (int i = 0; i < 2; ++i) RB[i] = *(const u32x4*)(bg + (long)(64 * i) * ldb + (kt) * 64); } while (0)
#define LWRITE(buf, RA, RB) do { _Pragma("unroll") for (int i = 0; i < 4; ++i) *(u32x4*)(lds + (buf) * 32768 + woff + i * 8192) = RA[i]; \
    _Pragma("unroll") for (int i = 0; i < 2; ++i) *(u32x4*)(lds + 65536 + (buf) * 16384 + woff + i * 8192) = RB[i]; } while (0)
#define COMPUTE(buf) do { const char* As = lds + (buf) * 32768; const char* Bs = lds + 65536 + (buf) * 16384; \
    _Pragma("unroll") for (int ks = 0; ks < 4; ++ks) { \
      const bf16x8 a0 = *(const bf16x8*)(As + arow * 128 + (((ks * 2 + hi) ^ asw) << 4)); \
      const bf16x8 a1 = *(const bf16x8*)(As + (arow + 32) * 128 + (((ks * 2 + hi) ^ asw) << 4)); \
      const bf16x8 b0 = *(const bf16x8*)(Bs + brow * 128 + (((ks * 2 + hi) ^ bsw) << 4)); \
      const bf16x8 b1 = *(const bf16x8*)(Bs + (brow + 32) * 128 + (((ks * 2 + hi) ^ bsw) << 4)); \
      acc[0][0] = __builtin_amdgcn_mfma_f32_32x32x16_bf16(a0, b0, acc[0][0], 0, 0, 0); \
      acc[0][1] = __builtin_amdgcn_mfma_f32_32x32x16_bf16(a0, b1, acc[0][1], 0, 0, 0); \
      acc[1][0] = __builtin_amdgcn_mfma_f32_32x32x16_bf16(a1, b0, acc[1][0], 0, 0, 0); \
      acc[1][1] = __builtin_amdgcn_mfma_f32_32x32x16_bf16(a1, b1, acc[1][1], 0, 0, 0); } } while (0)
#pragma unroll
  for (int a = 0; a < 2; ++a)
#pragma unroll
    for (int b = 0; b < 2; ++b)
#pragma unroll
      for (int r = 0; r < 16; ++r) acc[a][b][r] = 0.f;
  const int nt = K >> 6;
  GLOAD(0, ra0, rb0); GLOAD(1, ra1, rb1); LWRITE(0, ra0, rb0); __syncthreads();
  for (int kt = 0; kt < nt; kt += 2) {
    if (kt + 2 < nt) GLOAD(kt + 2, ra0, rb0);
    COMPUTE(0);
    LWRITE(1, ra1, rb1);
    __syncthreads();
    if (kt + 3 < nt) GLOAD(kt + 3, ra1, rb1);
    COMPUTE(1);
    if (kt + 2 < nt) LWRITE(0, ra0, rb0);
    __syncthreads();
  }
#undef GLOAD
#undef LWRITE
#undef COMPUTE
}

template <bool SWAP>
__device__ __forceinline__ void gemm256_mainloop(const u16* __restrict__ A, int lda, const u16* __restrict__ Bt, int ldb, int K, char* lds,
                                                 f32x16 (&acc)[4][2], const int tid) {
  const int wid = tid >> 6, lane = tid & 63, r32 = lane & 31, hi = lane >> 5, wm = wid >> 2, wn = wid & 3;
  const int srcch = (tid & 7) ^ ((tid >> 4) & 7);
  const u16* ag = A + (long)(tid >> 3) * lda + srcch * 8;
  const u16* bg = Bt + (long)(tid >> 3) * ldb + srcch * 8;
  const int swz = (r32 >> 1) & 7;
  const int aoff = (wm * 128 + r32) * 128, boff = (wn * 64 + r32) * 128;
#define ISSUE(kt, st) do { _Pragma("unroll") for (int i = 0; i < 4; ++i) { \
      __builtin_amdgcn_global_load_lds((const unsigned*)(ag + (long)(64 * i) * lda + (kt) * 64), (unsigned*)(lds + (st) * 65536 + tid * 16 + i * 8192), 16, 0, 0); \
      __builtin_amdgcn_global_load_lds((const unsigned*)(bg + (long)(64 * i) * ldb + (kt) * 64), (unsigned*)(lds + (st) * 65536 + 32768 + tid * 16 + i * 8192), 16, 0, 0); } } while (0)
#pragma unroll
  for (int a = 0; a < 4; ++a)
#pragma unroll
    for (int b = 0; b < 2; ++b)
#pragma unroll
      for (int r = 0; r < 16; ++r) acc[a][b][r] = 0.f;
  const int nt = K >> 6;
  ISSUE(0, 0);
  for (int kt = 0; kt < nt; ++kt) {
    const int st = kt & 1;
    asm volatile("s_waitcnt vmcnt(0)" ::: "memory");
    __syncthreads();
    if (kt + 1 < nt) ISSUE(kt + 1, st ^ 1);
    const char* As = lds + st * 65536 + aoff; const char* Bs = lds + st * 65536 + 32768 + boff;
    bf16x8 a0[4], b0[2], a1[4], b1[2];
#define FRAGS(ks, AF, BF) do { const int co = (((ks) * 2 + hi) ^ swz) << 4; \
      _Pragma("unroll") for (int mb = 0; mb < 4; ++mb) AF[mb] = *(const bf16x8*)(As + mb * 4096 + co); \
      _Pragma("unroll") for (int nb = 0; nb < 2; ++nb) BF[nb] = *(const bf16x8*)(Bs + nb * 4096 + co); } while (0)
#define MMAS(AF, BF) do { _Pragma("unroll") for (int mb = 0; mb < 4; ++mb) _Pragma("unroll") for (int nb = 0; nb < 2; ++nb) \
      acc[mb][nb] = SWAP ? __builtin_amdgcn_mfma_f32_32x32x16_bf16(BF[nb], AF[mb], acc[mb][nb], 0, 0, 0) \
                         : __builtin_amdgcn_mfma_f32_32x32x16_bf16(AF[mb], BF[nb], acc[mb][nb], 0, 0, 0); } while (0)
#define SB() __builtin_amdgcn_sched_barrier(0)
    FRAGS(0, a0, b0); SB();
    FRAGS(1, a1, b1); SB();
    MMAS(a0, b0); SB();
    FRAGS(2, a0, b0); SB();
    MMAS(a1, b1); SB();
    FRAGS(3, a1, b1); SB();
    MMAS(a0, b0); SB();
    MMAS(a1, b1); SB();
#undef FRAGS
#undef MMAS
#undef SB
  }
  __syncthreads();
#undef ISSUE
}

constexpr int G160_STAGE = 160 * 128 + 256 * 128;
__device__ __forceinline__ void gemm160_mainloop(const u16* __restrict__ A, int lda, const u16* __restrict__ Bt, int ldb, int K, char* lds,
                                                 f32x16 (&acc)[5], const int tid) {
  const int wid = tid >> 6, lane = tid & 63, r32 = lane & 31, hi = lane >> 5;
  const int srcch = (tid & 7) ^ ((tid >> 4) & 7);
  const u16* ag = A + (long)(tid >> 3) * lda + srcch * 8;
  const u16* bg = Bt + (long)(tid >> 3) * ldb + srcch * 8;
  const int swz = (r32 >> 1) & 7;
  const int aoff = r32 * 128, boff = 20480 + (wid * 32 + r32) * 128;
  const bool a3 = tid < 256;
#define ISSUE(kt, st) do { \
    _Pragma("unroll") for (int i = 0; i < 2; ++i) \
      __builtin_amdgcn_global_load_lds((const unsigned*)(ag + (long)(64 * i) * lda + (kt) * 64), (unsigned*)(lds + (st) * G160_STAGE + tid * 16 + i * 8192), 16, 0, 0); \
    if (a3) __builtin_amdgcn_global_load_lds((const unsigned*)(ag + (long)128 * lda + (kt) * 64), (unsigned*)(lds + (st) * G160_STAGE + tid * 16 + 16384), 16, 0, 0); \
    _Pragma("unroll") for (int i = 0; i < 4; ++i) \
      __builtin_amdgcn_global_load_lds((const unsigned*)(bg + (long)(64 * i) * ldb + (kt) * 64), (unsigned*)(lds + (st) * G160_STAGE + 20480 + tid * 16 + i * 8192), 16, 0, 0); } while (0)
#pragma unroll
  for (int a = 0; a < 5; ++a)
#pragma unroll
    for (int r = 0; r < 16; ++r) acc[a][r] = 0.f;
  const int nt = K >> 6;
  ISSUE(0, 0);
  for (int kt = 0; kt < nt; ++kt) {
    const int st = kt & 1;
    asm volatile("s_waitcnt vmcnt(0)" ::: "memory");
    __syncthreads();
    if (kt + 1 < nt) ISSUE(kt + 1, st ^ 1);
    const char* As = lds + st * G160_STAGE + aoff; const char* Bs = lds + st * G160_STAGE + boff;
    bf16x8 a0[5], b0, a1[5], b1;
#define FRAGS(ks, AF, BF) do { const int co = (((ks) * 2 + hi) ^ swz) << 4; \
      _Pragma("unroll") for (int mb = 0; mb < 5; ++mb) AF[mb] = *(const bf16x8*)(As + mb * 4096 + co); \
      BF = *(const bf16x8*)(Bs + co); } while (0)
#define MMAS(AF, BF) do { _Pragma("unroll") for (int mb = 0; mb < 5; ++mb) acc[mb] = __builtin_amdgcn_mfma_f32_32x32x16_bf16(BF, AF[mb], acc[mb], 0, 0, 0); } while (0)
#define SB() __builtin_amdgcn_sched_barrier(0)
    FRAGS(0, a0, b0); SB();
    FRAGS(1, a1, b1); SB();
    MMAS(a0, b0); SB();
    FRAGS(2, a0, b0); SB();
    MMAS(a1, b1); SB();
    FRAGS(3, a1, b1); SB();
    MMAS(a0, b0); SB();
    MMAS(a1, b1); SB();
#undef FRAGS
#undef MMAS
#undef SB
  }
  __syncthreads();
#undef ISSUE
}

using f32x4 = __attribute__((ext_vector_type(4))) float;
__device__ __forceinline__ void gemm160x16_mainloop(const u16* __restrict__ A, int lda, const u16* __restrict__ Bt, int ldb, int K, char* lds,
                                                    f32x4 (&acc)[10][2], const int tid) {
  const int wid = tid >> 6, lane = tid & 63, l16 = lane & 15, q4 = lane >> 4;
  const int srcch = (tid & 7) ^ ((tid >> 4) & 7);
  const u16* ag = A + (long)(tid >> 3) * lda + srcch * 8;
  const u16* bg = Bt + (long)(tid >> 3) * ldb + srcch * 8;
  const int swz = (l16 >> 1) & 7;
  const int aoff = l16 * 128, boff = 20480 + (wid * 32 + l16) * 128;
  const bool a3 = tid < 256;
#define ISSUE(kt, st) do { \
    _Pragma("unroll") for (int i = 0; i < 2; ++i) \
      __builtin_amdgcn_global_load_lds((const unsigned*)(ag + (long)(64 * i) * lda + (kt) * 64), (unsigned*)(lds + (st) * G160_STAGE + tid * 16 + i * 8192), 16, 0, 0); \
    if (a3) __builtin_amdgcn_global_load_lds((const unsigned*)(ag + (long)128 * lda + (kt) * 64), (unsigned*)(lds + (st) * G160_STAGE + tid * 16 + 16384), 16, 0, 0); \
    _Pragma("unroll") for (int i = 0; i < 4; ++i) \
      __builtin_amdgcn_global_load_lds((const unsigned*)(bg + (long)(64 * i) * ldb + (kt) * 64), (unsigned*)(lds + (st) * G160_STAGE + 20480 + tid * 16 + i * 8192), 16, 0, 0); } while (0)
#pragma unroll
  for (int a = 0; a < 10; ++a)
#pragma unroll
    for (int b = 0; b < 2; ++b) acc[a][b] = (f32x4){0.f, 0.f, 0.f, 0.f};
  const int nt = K >> 6;
  ISSUE(0, 0);
  for (int kt = 0; kt < nt; ++kt) {
    const int st = kt & 1;
    asm volatile("s_waitcnt vmcnt(0)" ::: "memory");
    __syncthreads();
    if (kt + 1 < nt) ISSUE(kt + 1, st ^ 1);
    const char* As = lds + st * G160_STAGE + aoff; const char* Bs = lds + st * G160_STAGE + boff;
    bf16x8 a0[10], b0[2], a1[10], b1[2];
#define FRAGS(ks, AF, BF) do { const int co = (((ks) * 4 + q4) ^ swz) << 4; \
      _Pragma("unroll") for (int mb = 0; mb < 10; ++mb) AF[mb] = *(const bf16x8*)(As + mb * 2048 + co); \
      _Pragma("unroll") for (int nb = 0; nb < 2; ++nb) BF[nb] = *(const bf16x8*)(Bs + nb * 2048 + co); } while (0)
#define MMAS(AF, BF) do { _Pragma("unroll") for (int mb = 0; mb < 10; ++mb) _Pragma("unroll") for (int nb = 0; nb < 2; ++nb) \
      acc[mb][nb] = __builtin_amdgcn_mfma_f32_16x16x32_bf16(BF[nb], AF[mb], acc[mb][nb], 0, 0, 0); } while (0)
#define SB() __builtin_amdgcn_sched_barrier(0)
    FRAGS(0, a0, b0); SB();
    FRAGS(1, a1, b1); SB();
    MMAS(a0, b0); SB();
    MMAS(a1, b1); SB();
#undef FRAGS
#undef MMAS
#undef SB
  }
  __syncthreads();
#undef ISSUE
}

__device__ __forceinline__ void gemm256x16_mainloop(const u16* __restrict__ A, int lda, const u16* __restrict__ Bt, int ldb, int K, char* lds,
                                                    f32x4 (&acc)[8][4], const int tid) {
  const int wid = tid >> 6, lane = tid & 63, l16 = lane & 15, q4 = lane >> 4, wm = wid >> 2, wn = wid & 3;
  const int srcch = (tid & 7) ^ ((tid >> 4) & 7);
  const u16* ag = A + (long)(tid >> 3) * lda + srcch * 8;
  const u16* bg = Bt + (long)(tid >> 3) * ldb + srcch * 8;
  const int swz = (l16 >> 1) & 7;
  const int aoff = (wm * 128 + l16) * 128, boff = (wn * 64 + l16) * 128;
#define ISSUE(kt, st) do { _Pragma("unroll") for (int i = 0; i < 4; ++i) { \
      __builtin_amdgcn_global_load_lds((const unsigned*)(ag + (long)(64 * i) * lda + (kt) * 64), (unsigned*)(lds + (st) * 65536 + tid * 16 + i * 8192), 16, 0, 0); \
      __builtin_amdgcn_global_load_lds((const unsigned*)(bg + (long)(64 * i) * ldb + (kt) * 64), (unsigned*)(lds + (st) * 65536 + 32768 + tid * 16 + i * 8192), 16, 0, 0); } } while (0)
#pragma unroll
  for (int a = 0; a < 8; ++a)
#pragma unroll
    for (int b = 0; b < 4; ++b) acc[a][b] = (f32x4){0.f, 0.f, 0.f, 0.f};
  const int nt = K >> 6;
  ISSUE(0, 0);
  for (int kt = 0; kt < nt; ++kt) {
    const int st = kt & 1;
    asm volatile("s_waitcnt vmcnt(0)" ::: "memory");
    __syncthreads();
    if (kt + 1 < nt) ISSUE(kt + 1, st ^ 1);
    const char* As = lds + st * 65536 + aoff; const char* Bs = lds + st * 65536 + 32768 + boff;
    bf16x8 aA[4], aB[4], bA[4];
#define LDA(ks, h, AF) do { const int co = (((ks) * 4 + q4) ^ swz) << 4; \
      _Pragma("unroll") for (int mb = 0; mb < 4; ++mb) AF[mb] = *(const bf16x8*)(As + ((h) * 4 + mb) * 2048 + co); } while (0)
#define LDB(ks, BF) do { const int co = (((ks) * 4 + q4) ^ swz) << 4; \
      _Pragma("unroll") for (int nb = 0; nb < 4; ++nb) BF[nb] = *(const bf16x8*)(Bs + nb * 2048 + co); } while (0)
#define MMAS(h, AF, BF) do { _Pragma("unroll") for (int mb = 0; mb < 4; ++mb) _Pragma("unroll") for (int nb = 0; nb < 4; ++nb) \
      acc[(h) * 4 + mb][nb] = __builtin_amdgcn_mfma_f32_16x16x32_bf16(BF[nb], AF[mb], acc[(h) * 4 + mb][nb], 0, 0, 0); } while (0)
#define SB() __builtin_amdgcn_sched_barrier(0)
    LDB(0, bA); LDA(0, 0, aA); SB();
    LDA(0, 1, aB); SB();
    MMAS(0, aA, bA); SB();
    LDA(1, 0, aA); SB();
    MMAS(1, aB, bA); SB();
    LDB(1, bA); LDA(1, 1, aB); SB();
    MMAS(0, aA, bA); SB();
    MMAS(1, aB, bA); SB();
#undef LDA
#undef LDB
#undef MMAS
#undef SB
  }
  __syncthreads();
#undef ISSUE
}

__device__ __forceinline__ int xcd_tile_index(int it) {
  return (gridDim.x == 256) ? ((it * 8 + (int)(blockIdx.x & 7)) * 32 + (int)(blockIdx.x >> 3)) : (int)(blockIdx.x + it * gridDim.x);
}
#define EPI_OFF(var, expr) long var = (long)(expr); asm volatile("" : "+v"(var) :: "memory")
#define CROW0(r) (((r) & 3) + 8 * ((r) >> 2))
#define WAVE_COORDS const int tid = opaque_tid(), wid = tid >> 6, lane = tid & 63, r32 = lane & 31, hi = lane >> 5, wm = wid >> 1, wn = wid & 1; (void)tid; (void)wm; (void)wn; (void)r32; (void)hi

__device__ __forceinline__ void phase_gemm_in(const Params& p_unused_, int l, char* lds) {
  PHASE_PARAMS;
  char* wsb = p.ws; asm volatile("" : "+s"(wsb));
  const int tid = opaque_tid(), wid = tid >> 6, lane = tid & 63, l16 = lane & 15, q4 = lane >> 4;
  const u16* h = (const u16*)(wsb + OFF_C);
  const u16* wt = (const u16*)(wsb + OFF_W + (size_t)l * WL_SIZE + WL_IN);
  u16* proj = (u16*)(wsb + A_PROJ);
  for (int it = 0;; ++it) {
    const int t = xcd_tile_index(it);
    if (t >= 256 * 5) break;
    const int mt = (t / 40) * 8 + (t & 7), nt = (t >> 3) % 5;
    f32x4 acc[10][2];
    gemm160x16_mainloop(h + (size_t)mt * 160 * 1024, 1024, wt + (size_t)nt * 256 * 1024, 1024, 1024, lds, acc, tid);
    const int col = nt * 256 + wid * 32 + q4 * 4;
#pragma unroll
    for (int mb = 0; mb < 10; ++mb) {
      EPI_OFF(eo, (long)(mt * 160 + mb * 16 + l16) * IN_COLS + col);
#pragma unroll
      for (int nb = 0; nb < 2; ++nb)
        if (col + 16 * nb < IN_COLS) {
          u32x2 w = {cvtpk(acc[mb][nb][0], acc[mb][nb][1]), cvtpk(acc[mb][nb][2], acc[mb][nb][3])};
          *(u32x2*)(proj + eo + 16 * nb) = w;
        }
    }
  }
}

__device__ __forceinline__ void phase_gemm_mix(const Params& p_unused_, int l, char* lds) {
  PHASE_PARAMS;
  char* wsb = p.ws; asm volatile("" : "+s"(wsb));
  WAVE_COORDS;
  char* wl = wsb + OFF_W + (size_t)l * WL_SIZE;
  const u16* proj = (const u16*)(wsb + A_PROJ);
  u16* mix = (u16*)(wsb + OFF_C);
  const float2* tab = (const float2*)(wsb + OFF_TAB);
  for (int it = 0;; ++it) {
    const int t = xcd_tile_index(it);
    if (t >= 3008) break;
    f32x16 acc[2][2];
    if (t < 960) {
      const int mt = t / 6, nt = t % 6;
      gemm_mainloop((const u16*)(wsb + A_QAN) + (size_t)mt * 256 * 256, 256, (const u16*)(wl + WL_QB) + (size_t)nt * 128 * 256, 256, 256, lds, acc, tid);
      u16* q = (u16*)(wsb + B_Q);
      const bool lat = mt >= 32;
#pragma unroll
      for (int mb = 0; mb < 2; ++mb)
#pragma unroll
        for (int nb = 0; nb < 2; ++nb) {
          const int n = nt * 128 + wn * 64 + nb * 32 + r32;
          const bool ropeblk = ((n >> 5) % 3) == 2;
          int m0q = mt * 256 + wm * 64 + mb * 32 + 4 * hi; asm volatile("" : "+v"(m0q) :: "memory");
          const long eo = (long)m0q * 768 + n;
#pragma unroll
          for (int r = 0; r < 16; ++r) {
            const int m = m0q + CROW0(r);
            float v = acc[mb][nb][r];
            if (lat && ropeblk) {
              const float pv = __shfl_xor(v, 8);
              const int s = (m - M_CTX) & 4095;
              const int axis = r32 >> 4, half = (r32 >> 3) & 1, f = r32 & 7;
              const int pos = axis ? (s & 63) : (s >> 6);
              const float2 cs = tab[pos * 8 + f];
              v = half ? (v * cs.x + pv * cs.y) : (v * cs.x - pv * cs.y);
            }
            q[eo + CROW0(r) * 768] = f2bf(v);
          }
        }
    } else if (t < 2368) {
      const int tt = t - 960, mt = tt >> 3, nt = tt & 7;
      gemm_mainloop((const u16*)(wsb + A_CKV) + (size_t)mt * 256 * 128, 128, (const u16*)(wl + WL_KVB) + (size_t)nt * 128 * 128, 128, 128, lds, acc, tid);
      u16* kv = (u16*)(wsb + B_KV);
#pragma unroll
      for (int mb = 0; mb < 2; ++mb)
#pragma unroll
        for (int nb = 0; nb < 2; ++nb) {
          const int n = nt * 128 + wn * 64 + nb * 32 + r32;
          { EPI_OFF(eo, (long)(mt * 256 + wm * 64 + mb * 32 + 4 * hi) * 1024 + n);
            _Pragma("unroll") for (int r = 0; r < 16; ++r) kv[eo + CROW0(r) * 1024] = f2bf(acc[mb][nb][r]); }
        }
    } else if (t < 2688) {
      const int tt = t - 2368, mt = tt >> 1, nt = tt & 1;
      gemm_mainloop((const u16*)(wsb + A_DPOOL) + (size_t)mt * 256 * 256, 256, (const u16*)(wl + WL_POOL) + (size_t)nt * 128 * 256, 256, 256, lds, acc, tid);
#pragma unroll
      for (int mb = 0; mb < 2; ++mb)
#pragma unroll
        for (int nb = 0; nb < 2; ++nb) {
          const int n = nt * 128 + wn * 64 + nb * 32 + r32;
          const float ps = p.pool_scale[l * 256 + n];
          { EPI_OFF(eo, (long)(mt * 256 + wm * 64 + mb * 32 + 4 * hi) * 1024 + 512 + n);
            _Pragma("unroll") for (int r = 0; r < 16; ++r) mix[eo + CROW0(r) * 1024] = f2bf(acc[mb][nb][r] * ps); }
        }
    } else {
      const int tt = t - 2688, h = tt / 80, mt = tt % 80;
      gemm_mainloop((const u16*)(wsb + A_VT) + ((size_t)h * 20480 + (size_t)mt * 256) * 128, 128, (const u16*)(wl + WL_SGU) + (size_t)h * 128 * 128, 128, 128, lds, acc, tid);
      const int chunk = mt * 4 + wm;
#pragma unroll
      for (int nb = 0; nb < 2; ++nb) {
        const int qq = wn * 64 + nb * 32 + r32;
        const float bias = p.b_sgu[((size_t)l * 4 + h) * 128 + qq];
        const size_t tok = (size_t)chunk * 128 + qq;
#pragma unroll
        for (int mb = 0; mb < 2; ++mb)
#pragma unroll
          for (int j = 0; j < 4; ++j) {
            const int d0 = mb * 32 + 8 * j + 4 * hi;
            const u32x2 uw = *(const u32x2*)(proj + tok * IN_COLS + 672 + h * 64 + d0);
            const float o0 = (acc[mb][nb][4 * j + 0] + bias) * bflo(uw[0]), o1 = (acc[mb][nb][4 * j + 1] + bias) * bfhi(uw[0]);
            const float o2 = (acc[mb][nb][4 * j + 2] + bias) * bflo(uw[1]), o3 = (acc[mb][nb][4 * j + 3] + bias) * bfhi(uw[1]);
            u32x2 w = {cvtpk(o0, o1), cvtpk(o2, o3)};
            *(u32x2*)(mix + tok * 1024 + 768 + h * 64 + d0) = w;
          }
      }
    }
  }
}

__device__ __forceinline__ void phase_gemm_f32out(const Params& p_unused_, size_t a_off, int K, size_t w_off, char* lds) {
  PHASE_PARAMS;
  char* wsb = p.ws; asm volatile("" : "+s"(wsb));
  const int tid = opaque_tid(), wid = tid >> 6, lane = tid & 63, l16 = lane & 15, q4 = lane >> 4;
  u16* obuf = (u16*)(wsb + OFF_B);
  const u16* A = (const u16*)(wsb + a_off); const u16* wt = (const u16*)(wsb + w_off);
  for (int it = 0;; ++it) {
    const int t = xcd_tile_index(it);
    if (t >= 256 * 4) break;
    const int mt = (t >> 5) * 8 + (t & 7), nt = (t >> 3) & 3;
    f32x4 acc[10][2];
    gemm160x16_mainloop(A + (size_t)mt * 160 * K, K, wt + (size_t)nt * 256 * K, K, K, lds, acc, tid);
#pragma unroll
    for (int mb = 0; mb < 10; ++mb) {
      EPI_OFF(eo, (long)(mt * 160 + mb * 16 + l16) * 1024 + nt * 256 + wid * 32 + q4 * 4);
#pragma unroll
      for (int nb = 0; nb < 2; ++nb) {
        u32x2 w = {cvtpk(acc[mb][nb][0], acc[mb][nb][1]), cvtpk(acc[mb][nb][2], acc[mb][nb][3])};
        *(u32x2*)(obuf + eo + 16 * nb) = w;
      }
    }
  }
}

constexpr int ZP = 264;
__device__ __forceinline__ void unpack8(const u32x4 w, float* f) {
  f[0] = bflo(w[0]); f[1] = bfhi(w[0]); f[2] = bflo(w[1]); f[3] = bfhi(w[1]); f[4] = bflo(w[2]); f[5] = bfhi(w[2]); f[6] = bflo(w[3]); f[7] = bfhi(w[3]);
}
__device__ __forceinline__ void phase_gemm_up(const Params& p_unused_, int l, char* lds) {
  PHASE_PARAMS;
  char* wsb = p.ws; asm volatile("" : "+s"(wsb));
  const int tid = opaque_tid(), wid = tid >> 6, lane = tid & 63, r32 = lane & 31, hi = lane >> 5, wm = wid >> 2, wn = wid & 3;
  const u16* h = (const u16*)(wsb + OFF_C);
  const u16* wt = (const u16*)(wsb + OFF_W + (size_t)l * WL_SIZE + WL_UP);
  u16* act_ = (u16*)(wsb + OFF_A);
  u16* halo_ = (u16*)(wsb + OFF_B);
  u16* zs = (u16*)lds;
  const float* cw_ = p.conv_w + (size_t)l * 3 * 5632;
  const float* cb_ = p.conv_b + (size_t)l * 5632;
  for (int it = 0;; ++it) {
    const int t = xcd_tile_index(it);
    if (t >= 160 * 22) break;
    const int mt = (t / 176) * 8 + (t & 7), nt = (t >> 3) % 22;
    f32x4 acc[8][4];
    gemm256x16_mainloop(h + (size_t)mt * 256 * 1024, 1024, wt + (size_t)nt * 256 * 1024, 1024, 1024, lds, acc, tid);
    {
      const int l16 = lane & 15, q4 = lane >> 4;
#pragma unroll
      for (int mb = 0; mb < 8; ++mb) {
        EPI_OFF(zo, (wm * 128 + mb * 16 + l16) * ZP + wn * 32 + q4 * 4);
#pragma unroll
        for (int nb = 0; nb < 4; ++nb) {
          u32x2 w = {cvtpk(acc[mb][nb][0], acc[mb][nb][1]), cvtpk(acc[mb][nb][2], acc[mb][nb][3])};
          *(u32x2*)(zs + zo + (nb >> 1) * 128 + (nb & 1) * 16) = w;
        }
      }
    }
    const int fch = tid & 15, rg = tid >> 4;
    int fg = nt * 128 + fch * 8;
    asm volatile("" : "+v"(fg) :: "memory");
    const float* cw = cw_; const float* cb = cb_; u16* act = act_; u16* halo = halo_;
    asm volatile("" : "+v"(cw), "+v"(cb), "+v"(act), "+v"(halo));
    const bool lat = mt >= 32;
    const bool top_zero = !lat || (((mt - 32) & 15) == 0), bot_zero = !lat || (((mt - 32) & 15) == 15);
    float cwg[3][8], cwv[3][8], cbg[8], cbv[8];
#pragma unroll
    for (int tp = 0; tp < 3; ++tp) {
      const float4 g0 = *(const float4*)(cw + tp * 5632 + fg), g1 = *(const float4*)(cw + tp * 5632 + fg + 4);
      const float4 v0 = *(const float4*)(cw + tp * 5632 + DFF + fg), v1 = *(const float4*)(cw + tp * 5632 + DFF + fg + 4);
      cwg[tp][0] = g0.x; cwg[tp][1] = g0.y; cwg[tp][2] = g0.z; cwg[tp][3] = g0.w; cwg[tp][4] = g1.x; cwg[tp][5] = g1.y; cwg[tp][6] = g1.z; cwg[tp][7] = g1.w;
      cwv[tp][0] = v0.x; cwv[tp][1] = v0.y; cwv[tp][2] = v0.z; cwv[tp][3] = v0.w; cwv[tp][4] = v1.x; cwv[tp][5] = v1.y; cwv[tp][6] = v1.z; cwv[tp][7] = v1.w;
    }
    {
      const float4 g0 = *(const float4*)(cb + fg), g1 = *(const float4*)(cb + fg + 4), v0 = *(const float4*)(cb + DFF + fg), v1 = *(const float4*)(cb + DFF + fg + 4);
      cbg[0] = g0.x; cbg[1] = g0.y; cbg[2] = g0.z; cbg[3] = g0.w; cbg[4] = g1.x; cbg[5] = g1.y; cbg[6] = g1.z; cbg[7] = g1.w;
      cbv[0] = v0.x; cbv[1] = v0.y; cbv[2] = v0.z; cbv[3] = v0.w; cbv[4] = v1.x; cbv[5] = v1.y; cbv[6] = v1.z; cbv[7] = v1.w;
    }
    __syncthreads();
    const int r0 = rg * 8;
    const u16* zg = zs + fch * 8;
    float pg[8], pv[8], cg[8], cv[8], ng[8], nv[8];
    if (r0 > 0) { unpack8(*(const u32x4*)(zg + (r0 - 1) * ZP), pg); unpack8(*(const u32x4*)(zg + (r0 - 1) * ZP + 128), pv); }
    else {
#pragma unroll
      for (int e = 0; e < 8; ++e) { pg[e] = 0.f; pv[e] = 0.f; }
    }
    unpack8(*(const u32x4*)(zg + r0 * ZP), cg); unpack8(*(const u32x4*)(zg + r0 * ZP + 128), cv);
#pragma unroll
    for (int j = 0; j < 8; ++j) {
      const int row = r0 + j;
      if (row < 255) { unpack8(*(const u32x4*)(zg + (row + 1) * ZP), ng); unpack8(*(const u32x4*)(zg + (row + 1) * ZP + 128), nv); }
      else {
#pragma unroll
        for (int e = 0; e < 8; ++e) { ng[e] = 0.f; nv[e] = 0.f; }
      }
      if (lat && (row < 2 || row >= 254)) {
        const int hr = row < 2 ? row : row - 252;
        *(u32x4*)(halo + ((size_t)mt * 4 + hr) * 5632 + fg) = *(const u32x4*)(zg + row * ZP);
        *(u32x4*)(halo + ((size_t)mt * 4 + hr) * 5632 + DFF + fg) = *(const u32x4*)(zg + row * ZP + 128);
      }
      const bool skip = (row == 0 && !top_zero) || (row == 255 && !bot_zero);
      if (!skip) {
        float o[8];
#pragma unroll
        for (int e = 0; e < 8; ++e) {
          const float gg = cwg[0][e] * pg[e] + cwg[1][e] * cg[e] + cwg[2][e] * ng[e] + cbg[e];
          const float vv = cwv[0][e] * pv[e] + cwv[1][e] * cv[e] + cwv[2][e] * nv[e] + cbv[e];
          o[e] = silu_f(gg) * vv;
        }
        u32x4 w = {cvtpk(o[0], o[1]), cvtpk(o[2], o[3]), cvtpk(o[4], o[5]), cvtpk(o[6], o[7])};
        *(u32x4*)(act + (size_t)(mt * 256 + row) * DFF + fg) = w;
      }
#pragma unroll
      for (int e = 0; e < 8; ++e) { pg[e] = cg[e]; pv[e] = cv[e]; cg[e] = ng[e]; cv[e] = nv[e]; }
    }
    __syncthreads();
  }
}

__device__ __forceinline__ void phase_fixup(const Params& p_unused_, int l) {
  PHASE_PARAMS;
  char* wsb = p.ws; asm volatile("" : "+s"(wsb));
  const int tid = opaque_tid();
  u16* act = (u16*)(wsb + OFF_A);
  const u16* halo = (const u16*)(wsb + OFF_B);
  const float* cw = p.conv_w + (size_t)l * 3 * 5632;
  const float* cb = p.conv_b + (size_t)l * 5632;
  for (int u = blockIdx.x; u < 256; u += gridDim.x) {
    const int mt = 32 + (u >> 1), e = u & 1;
    const int row = e ? 255 : 0, m = mt * 256 + row, s = (m - M_CTX) & 4095;
    if ((e == 0 && s == 0) || (e == 1 && s == S_LAT - 1)) continue;
    const u16* up = e == 0 ? halo + ((size_t)(mt - 1) * 4 + 3) * 5632 : halo + ((size_t)mt * 4 + 2) * 5632;
    const u16* own = e == 0 ? halo + ((size_t)mt * 4 + 0) * 5632 : halo + ((size_t)mt * 4 + 3) * 5632;
    const u16* dn = e == 0 ? halo + ((size_t)mt * 4 + 1) * 5632 : halo + ((size_t)(mt + 1) * 4 + 0) * 5632;
    for (int f = tid; f < DFF; f += NTHR) {
      const float gg = cw[f] * bf2f(up[f]) + cw[5632 + f] * bf2f(own[f]) + cw[2 * 5632 + f] * bf2f(dn[f]) + cb[f];
      const float vv = cw[DFF + f] * bf2f(up[DFF + f]) + cw[5632 + DFF + f] * bf2f(own[DFF + f]) + cw[2 * 5632 + DFF + f] * bf2f(dn[DFF + f]) + cb[DFF + f];
      act[(size_t)m * DFF + f] = f2bf(silu_f(gg) * vv);
    }
  }
}

constexpr int VSP = 264;
__device__ __forceinline__ void phase_mid(const Params& p_unused_, int l, char* lds) {
  PHASE_PARAMS;
  char* wsb = p.ws; asm volatile("" : "+s"(wsb));
  const int tid = opaque_tid(), wid = tid >> 6, lane = tid & 63;
  const u16* proj = (const u16*)(wsb + A_PROJ);
  u16* qan = (u16*)(wsb + A_QAN);
  u16* ckva = (u16*)(wsb + A_CKV);
  u16* dpool = (u16*)(wsb + A_DPOOL);
  u16* vT = (u16*)(wsb + A_VT);
  u16* krope = (u16*)(wsb + B_KR);
  const float2* tab = (const float2*)(wsb + OFF_TAB);
  u16* vs = (u16*)lds;
  const float4 c_gq = *(const float4*)(p.g_q_a + l * 256 + lane * 4), c_gs = *(const float4*)(p.g_sgu + l * 256 + lane * 4);
  const float2 c_gk = *(const float2*)(p.g_kv_a + l * 128 + lane * 2);
  for (int it = 0;; ++it) {
    const int u = xcd_tile_index(it);
    if (u >= 704) break;
    if (u < 640) {
      const int chunk = u >> 1, half = u & 1;
      float a0 = 0.f, a1 = 0.f, a2 = 0.f, a3 = 0.f; int pw_lo = 0, pw_hi = 0;
      for (int tl = wid * 8; tl < wid * 8 + 8; ++tl) {
        const int m = u * 64 + tl;
        const bool ctx = m < M_CTX;
        int b, s, S, kvrow;
        if (ctx) { b = m >> 8; s = m & 255; S = S_CTX; kvrow = m; }
        else { const int mm = m - M_CTX; b = mm >> 12; s = mm & 4095; S = S_LAT; kvrow = M_CTX + b * T_LAT + PAST + s; }
        const u16* pr = proj + (size_t)m * IN_COLS;
        {
          const u32x2 w = *(const u32x2*)(pr + lane * 4);
          const float x0 = bflo(w[0]), x1 = bfhi(w[0]), x2 = bflo(w[1]), x3 = bfhi(w[1]);
          const float ss = wave_sum(x0 * x0 + x1 * x1 + x2 * x2 + x3 * x3);
          const float rstd = rsqrtf(ss * (1.f / 256.f) + EPS);
          const float4 g = c_gq;
          u32x2 o = {cvtpk(x0 * rstd * g.x, x1 * rstd * g.y), cvtpk(x2 * rstd * g.z, x3 * rstd * g.w)};
          *(u32x2*)(qan + (size_t)m * 256 + lane * 4) = o;
        }
        {
          const unsigned w = *(const unsigned*)(pr + 256 + lane * 2);
          const float x0 = bflo(w), x1 = bfhi(w);
          const float ss = wave_sum(x0 * x0 + x1 * x1);
          const float rstd = rsqrtf(ss * (1.f / 128.f) + EPS);
          const float2 g = c_gk;
          const float y0 = x0 * rstd * g.x, y1 = x1 * rstd * g.y;
          *(unsigned*)(ckva + (size_t)kvrow * 128 + lane * 2) = cvtpk(y0, y1);
          if (ctx) *(float2*)(p.out + OUT_CKV + (((size_t)b * 2 + l) * 256 + s) * 128 + lane * 2) = make_float2(y0, y1);
        }
        {
          const float x = bf2f(pr[384 + (lane & 31)]);
          const float pv = __shfl_xor(x, 8);
          float y = x;
          if (!ctx) {
            const int rr = lane & 31, axis = rr >> 4, half = (rr >> 3) & 1, f = rr & 7;
            const int pos = axis ? (s & 63) : (s >> 6);
            const float2 cs = tab[pos * 8 + f];
            y = half ? (x * cs.x + pv * cs.y) : (x * cs.x - pv * cs.y);
          }
          if (lane < 32) {
            krope[(size_t)kvrow * 32 + lane] = f2bf(y);
            if (ctx) p.out[OUT_KR + (((size_t)b * 2 + l) * 256 + s) * 32 + lane] = x;
          }
        }
        {
          const int g = lane >> 4, half = 1 << g;
          const int lo = max(s - half, 0), hi_ = min(s + half, S);
          const u16* pb = proj + (size_t)(m - s) * IN_COLS + 416 + lane * 4;
          for (int t = max(pw_hi, lo); t < hi_; ++t) {
            const u32x2 w = *(const u32x2*)(pb + (size_t)t * IN_COLS);
            a0 += bflo(w[0]); a1 += bfhi(w[0]); a2 += bflo(w[1]); a3 += bfhi(w[1]);
          }
          for (int t = pw_lo; t < min(lo, pw_hi); ++t) {
            const u32x2 w = *(const u32x2*)(pb + (size_t)t * IN_COLS);
            a0 -= bflo(w[0]); a1 -= bfhi(w[0]); a2 -= bflo(w[1]); a3 -= bfhi(w[1]);
          }
          pw_lo = lo; pw_hi = hi_;
          const u32x2 w = *(const u32x2*)(pb + (size_t)s * IN_COLS);
          const float inv = __builtin_amdgcn_rcpf((float)(hi_ - lo));
          u32x2 o = {cvtpk(a0 * inv - bflo(w[0]), a1 * inv - bfhi(w[0])), cvtpk(a2 * inv - bflo(w[1]), a3 * inv - bfhi(w[1]))};
          *(u32x2*)(dpool + (size_t)m * 256 + lane * 4) = o;
        }
        {
          const u32x2 w = *(const u32x2*)(pr + 928 + lane * 4);
          const float x0 = bflo(w[0]), x1 = bfhi(w[0]), x2 = bflo(w[1]), x3 = bfhi(w[1]);
          const float ss = wave_sum(x0 * x0 + x1 * x1 + x2 * x2 + x3 * x3);
          const float rstd = rsqrtf(ss * (1.f / 256.f) + EPS);
          const float4 g = c_gs;
          u32x2 o = {cvtpk(x0 * rstd * g.x, x1 * rstd * g.y), cvtpk(x2 * rstd * g.z, x3 * rstd * g.w)};
          *(u32x2*)(vs + tl * VSP + lane * 4) = o;
        }
      }
      __syncthreads();
#pragma unroll 1
      for (int i = 0; i < 4; ++i) {
        const int hd = (tid >> 3) + 64 * i, ps = tid & 7, h = hd >> 6, d = hd & 63;
        u16 e[8];
#pragma unroll
        for (int j = 0; j < 8; ++j) e[j] = vs[(ps * 8 + j) * VSP + hd];
        u32x4 w = {(unsigned)e[0] | ((unsigned)e[1] << 16), (unsigned)e[2] | ((unsigned)e[3] << 16), (unsigned)e[4] | ((unsigned)e[5] << 16), (unsigned)e[6] | ((unsigned)e[7] << 16)};
        *(u32x4*)(vT + (((size_t)h * 320 + chunk) * 64 + d) * 128 + half * 64 + ps * 8) = w;
      }
      __syncthreads();
    } else {
      const int uu = u - 640, b = uu >> 3, t0 = (uu & 7) * 64;
      for (int tl = wid; tl < 64; tl += 8) {
        const int t = t0 + tl; const size_t kvrow = (size_t)M_CTX + (size_t)b * T_LAT + t;
        const float2 v = *(const float2*)(p.cache_ckv + (((size_t)b * 2 + l) * PAST + t) * 128 + lane * 2);
        *(unsigned*)(ckva + kvrow * 128 + lane * 2) = cvtpk(v.x, v.y);
        if (lane < 32) krope[kvrow * 32 + lane] = f2bf(p.cache_krope[(((size_t)b * 2 + l) * PAST + t) * 32 + lane]);
      }
    }
  }
}

constexpr int SHM_V = 64 * 128 * 2, SHM_K = 64 * 128 * 2;
constexpr float ATT_SCALE = 0.10206207261596575f;
constexpr float ATT_THR = 8.f;
#define KSWZ(row, colB) ((row) * 256 + ((colB) ^ (((row) & 15) << 4)))
#define SBAR() __builtin_amdgcn_sched_barrier(0)

__device__ __forceinline__ void partialSM(f32x16& p0, f32x16& p1, float& m_reg, float& mn, float& alpha) {
  constexpr float C = ATT_SCALE * 1.4426950408889634f;
  float pmax = p0[0];
#pragma unroll
  for (int r = 1; r < 16; ++r) pmax = fmaxf(pmax, p0[r]);
#pragma unroll
  for (int r = 0; r < 16; ++r) pmax = fmaxf(pmax, p1[r]);
  { auto rr = __builtin_amdgcn_permlane32_swap(__float_as_uint(pmax), __float_as_uint(pmax), false, false);
    pmax = fmaxf(__uint_as_float(rr[0]), __uint_as_float(rr[1])); }
  if (__builtin_expect(__all(pmax - m_reg <= ATT_THR / ATT_SCALE), 1)) { mn = m_reg; alpha = 1.f; }
  else { mn = fmaxf(m_reg, pmax); alpha = __builtin_amdgcn_exp2f((m_reg - mn) * C); m_reg = mn; }
  const float mnC = -mn * C;
#pragma unroll
  for (int r = 0; r < 16; ++r) p0[r] = fmaf(p0[r], C, mnC);
#pragma unroll
  for (int r = 0; r < 16; ++r) p1[r] = fmaf(p1[r], C, mnC);
#pragma unroll
  for (int r = 0; r < 16; ++r) p0[r] = __builtin_amdgcn_exp2f(p0[r]);
}
__device__ __forceinline__ void finishSM(f32x16& p0, f32x16& p1, float alpha, float& l_reg, bf16x8& pa0, bf16x8& pa1, bf16x8& pa2, bf16x8& pa3) {
#pragma unroll
  for (int r = 0; r < 16; ++r) p1[r] = __builtin_amdgcn_exp2f(p1[r]);
  float ps = 0;
#pragma unroll
  for (int r = 0; r < 16; ++r) ps += p0[r];
#pragma unroll
  for (int r = 0; r < 16; ++r) ps += p1[r];
  { auto rr = __builtin_amdgcn_permlane32_swap(__float_as_uint(ps), __float_as_uint(ps), false, false);
    ps = __uint_as_float(rr[0]) + __uint_as_float(rr[1]); }
  l_reg = l_reg * alpha + ps;
#define PK4(P, BASE, OUT) do { unsigned a0 = cvtpk(P[BASE + 0], P[BASE + 1]), a1 = cvtpk(P[BASE + 2], P[BASE + 3]);   \
    unsigned b0 = cvtpk(P[BASE + 4], P[BASE + 5]), b1 = cvtpk(P[BASE + 6], P[BASE + 7]);                              \
    auto r0 = __builtin_amdgcn_permlane32_swap(a0, b0, false, false); auto r1 = __builtin_amdgcn_permlane32_swap(a1, b1, false, false); \
    u32x4 w = {r0[0], r1[0], r0[1], r1[1]}; OUT = *reinterpret_cast<bf16x8*>(&w); } while (0)
  PK4(p0, 0, pa0); PK4(p0, 8, pa1); PK4(p1, 0, pa2); PK4(p1, 8, pa3);
#undef PK4
}
__device__ __forceinline__ void qkt(f32x16& p0, f32x16& p1, const char* Ks, const bf16x8* qr, int r32, int hi) {
#pragma unroll
  for (int r = 0; r < 16; ++r) { p0[r] = 0.f; p1[r] = 0.f; }
#pragma unroll
  for (int d0 = 0; d0 < 6; ++d0) { const int cb = (d0 * 16 + hi * 8) * 2;
    const bf16x8 b0 = *reinterpret_cast<const bf16x8*>(Ks + KSWZ(r32, cb));
    const bf16x8 b1 = *reinterpret_cast<const bf16x8*>(Ks + KSWZ(32 + r32, cb));
    p0 = __builtin_amdgcn_mfma_f32_32x32x16_bf16(b0, qr[d0], p0, 0, 0, 0);
    p1 = __builtin_amdgcn_mfma_f32_32x32x16_bf16(b1, qr[d0], p1, 0, 0, 0); }
}
__device__ __forceinline__ int v_st(int k, int c) { const int kk = (k & ~0xC) | ((k & 4) << 1) | ((k & 8) >> 1); return ((kk >> 3) * 4 + (c >> 5)) * 512 + ((kk & 7) * 32 + (c & 31)) * 2; }
__device__ __forceinline__ int v_rd_base(int lane) { return ((lane & 3) << 3) | (((lane >> 2) & 3) << 6) | (((lane >> 4) & 1) << 5) | (((lane >> 5) & 1) << 8); }
constexpr int v_rd_off(int d0, int ks, int half) { return d0 * 512 + ks * 4096 + half * 2048; }
template <int OFF> __device__ __forceinline__ s16x4 tr_read(int vb) {
  s16x4 r; asm volatile("ds_read_b64_tr_b16 %0, %1 offset:%2" : "=&v"(r) : "v"(vb), "i"(OFF) : "memory"); return r;
}
template <int D0> __device__ __forceinline__ void pv_one(f32x16& od, int vb, bf16x8 pa0, bf16x8 pa1, bf16x8 pa2, bf16x8 pa3) {
  const s16x4 l0 = tr_read<v_rd_off(D0, 0, 0)>(vb), h0 = tr_read<v_rd_off(D0, 0, 1)>(vb), l1 = tr_read<v_rd_off(D0, 1, 0)>(vb), h1 = tr_read<v_rd_off(D0, 1, 1)>(vb);
  const s16x4 l2 = tr_read<v_rd_off(D0, 2, 0)>(vb), h2 = tr_read<v_rd_off(D0, 2, 1)>(vb), l3 = tr_read<v_rd_off(D0, 3, 0)>(vb), h3 = tr_read<v_rd_off(D0, 3, 1)>(vb);
  asm volatile("s_waitcnt lgkmcnt(0)" ::: "memory"); SBAR();
#define PK(L, H) (bf16x8){L[0], L[1], L[2], L[3], H[0], H[1], H[2], H[3]}
  od = __builtin_amdgcn_mfma_f32_32x32x16_bf16(pa0, PK(l0, h0), od, 0, 0, 0);
  od = __builtin_amdgcn_mfma_f32_32x32x16_bf16(pa1, PK(l1, h1), od, 0, 0, 0);
  od = __builtin_amdgcn_mfma_f32_32x32x16_bf16(pa2, PK(l2, h2), od, 0, 0, 0);
  od = __builtin_amdgcn_mfma_f32_32x32x16_bf16(pa3, PK(l3, h3), od, 0, 0, 0);
#undef PK
}
__device__ __forceinline__ void pv_d0(f32x16* o, int vb, bf16x8 pa0, bf16x8 pa1, bf16x8 pa2, bf16x8 pa3) {
  pv_one<0>(o[0], vb, pa0, pa1, pa2, pa3); pv_one<1>(o[1], vb, pa0, pa1, pa2, pa3);
}

__device__ __forceinline__ void attn_body(const u16* __restrict__ Qb, const u16* __restrict__ Kh, const u16* __restrict__ KRh,
                                          const u16* __restrict__ Vh, u16* __restrict__ Ob, int seq, char* lds) {
  const int tid = opaque_tid(), wid = tid >> 6, lane = tid & 63, r32 = lane & 31, hi = lane >> 5;
  char* V_lds = lds; char* K_lds = lds + 2 * SHM_V;
  float* ws = (float*)(lds + 2 * SHM_V + 2 * SHM_K) + wid * 64; float* li_l = ws; float* al_l = ws + 32;
  float m_reg = -1e30f, l_reg = 0; f32x16 o[2]; bf16x8 qr[6];
#pragma unroll
  for (int r = 0; r < 16; ++r) { o[0][r] = 0.f; o[1][r] = 0.f; }
  const u16* Qw = Qb + (long)(wid * 32 + r32) * 768 + hi * 8;
#pragma unroll
  for (int d0 = 0; d0 < 6; ++d0) qr[d0] = *reinterpret_cast<const bf16x8*>(Qw + d0 * 16);
  const int sr = tid >> 4, c16 = tid & 15;
  const u16* kp; int kstr;
  if (c16 < 8) { kp = Kh + (long)sr * 1024 + c16 * 8; kstr = 1024; } else { kp = KRh + (long)sr * 32 + ((c16 - 8) & 3) * 8; kstr = 32; }
  const int kst0 = KSWZ(sr, c16 * 16), kst1 = KSWZ(32 + sr, c16 * 16);
  const int vkey = tid >> 3, vc = (tid & 7) * 8; const u16* vp = Vh + (long)vkey * 1024 + vc; const int vst = v_st(vkey, vc);
  const int vb0 = (int)(uintptr_t)V_lds + v_rd_base(lane);
  bf16x8 sv0, sk00, sk01, sv1, sk10, sk11;
#define SLOAD0(k0) do { sv0 = *(const bf16x8*)(vp + (long)(k0) * 1024); sk00 = *(const bf16x8*)(kp + (long)(k0) * kstr); sk01 = *(const bf16x8*)(kp + (long)((k0) + 32) * kstr); } while (0)
#define SLOAD1(k0) do { sv1 = *(const bf16x8*)(vp + (long)(k0) * 1024); sk10 = *(const bf16x8*)(kp + (long)(k0) * kstr); sk11 = *(const bf16x8*)(kp + (long)((k0) + 32) * kstr); } while (0)
#define SWRITE0(b) do { *(bf16x8*)(V_lds + (b) * SHM_V + vst) = sv0; *(bf16x8*)(K_lds + (b) * SHM_K + kst0) = sk00; *(bf16x8*)(K_lds + (b) * SHM_K + kst1) = sk01; } while (0)
#define SWRITE1(b) do { *(bf16x8*)(V_lds + (b) * SHM_V + vst) = sv1; *(bf16x8*)(K_lds + (b) * SHM_K + kst0) = sk10; *(bf16x8*)(K_lds + (b) * SHM_K + kst1) = sk11; } while (0)
#define SWAIT() asm volatile("s_waitcnt vmcnt(3)" ::: "memory")
#define RESC(a) do { if (__any((a) < 1.f)) { if (hi == 0) al_l[r32] = (a); asm volatile("s_waitcnt lgkmcnt(0)" ::: "memory"); \
    _Pragma("unroll") for (int d = 0; d < 2; ++d) _Pragma("unroll") for (int r = 0; r < 16; ++r) o[d][r] *= al_l[crow(r, hi)]; } } while (0)
  f32x16 pA0, pA1, pB0, pB1; float mnA, mnB, alA, alB; bf16x8 pa0, pa1, pa2, pa3; const int NT = seq / 64;
  SLOAD0(0); asm volatile("s_waitcnt vmcnt(0)" ::: "memory"); SWRITE0(0); __syncthreads();
  qkt(pA0, pA1, K_lds, qr, r32, hi); partialSM(pA0, pA1, m_reg, mnA, alA);
  SLOAD1(64); if (2 < NT) SLOAD0(2 * 64);
  SWAIT(); SWRITE1(1); __syncthreads();
  for (int j = 1; j + 1 < NT; j += 2) {
    SBAR(); qkt(pB0, pB1, K_lds + SHM_K, qr, r32, hi);
    finishSM(pA0, pA1, alA, l_reg, pa0, pa1, pa2, pa3); SBAR();
    SLOAD1((j + 2) * 64); SBAR();
    pv_d0(o, vb0, pa0, pa1, pa2, pa3); partialSM(pB0, pB1, m_reg, mnB, alB);
    __syncthreads(); SWAIT(); SWRITE0(0);
    RESC(alB); __syncthreads();
    SBAR(); qkt(pA0, pA1, K_lds, qr, r32, hi);
    finishSM(pB0, pB1, alB, l_reg, pa0, pa1, pa2, pa3); SBAR();
    if (j + 3 < NT) SLOAD0((j + 3) * 64); SBAR();
    pv_d0(o, vb0 + SHM_V, pa0, pa1, pa2, pa3); partialSM(pA0, pA1, m_reg, mnA, alA);
    __syncthreads(); SWAIT(); SWRITE1(1);
    RESC(alA); __syncthreads();
  }
  SBAR(); qkt(pB0, pB1, K_lds + SHM_K, qr, r32, hi);
  finishSM(pA0, pA1, alA, l_reg, pa0, pa1, pa2, pa3); SBAR();
  pv_d0(o, vb0, pa0, pa1, pa2, pa3); partialSM(pB0, pB1, m_reg, mnB, alB);
  __syncthreads(); RESC(alB);
  finishSM(pB0, pB1, alB, l_reg, pa0, pa1, pa2, pa3); SBAR();
  pv_d0(o, vb0 + SHM_V, pa0, pa1, pa2, pa3);
  if (hi == 0) li_l[r32] = l_reg; asm volatile("s_waitcnt lgkmcnt(0)" ::: "memory");
  u16* Ow = Ob + (long)(wid * 32) * 1024;
#pragma unroll
  for (int r = 0; r < 16; ++r) { const int orow = crow(r, hi); const float rl = __builtin_amdgcn_rcpf(li_l[orow]);
#pragma unroll
    for (int d0 = 0; d0 < 2; ++d0) Ow[(long)orow * 1024 + d0 * 32 + r32] = f2bf(o[d0][r] * rl); }
#undef SLOAD0
#undef SLOAD1
#undef SWRITE0
#undef SWRITE1
#undef SWAIT
#undef RESC
}

__device__ __forceinline__ void phase_attn(const Params& p_unused_, char* lds) {
  PHASE_PARAMS;
  char* wsb = p.ws; asm volatile("" : "+s"(wsb));
  const u16* q = (const u16*)(wsb + B_Q);
  const u16* kv = (const u16*)(wsb + B_KV);
  const u16* kr = (const u16*)(wsb + B_KR);
  u16* mix = (u16*)(wsb + OFF_C);
  for (int u = blockIdx.x; u < 1280; u += gridDim.x) {
    size_t m0, kvrow0; int h, seq;
    if (u < 1024) {
      const int it = u >> 8, i = u & 255, xcd = i & 7, j = i >> 3;
      const int bh = it * 16 + xcd * 2 + (j >> 4), qb = j & 15, b = bh >> 3;
      h = bh & 7; m0 = (size_t)M_CTX + (size_t)b * S_LAT + qb * 256; kvrow0 = (size_t)M_CTX + (size_t)b * T_LAT; seq = T_LAT;
    } else {
      const int uu = u - 1024, b = uu >> 3; h = uu & 7; m0 = (size_t)b * 256; kvrow0 = m0; seq = S_CTX;
    }
    __syncthreads();
    attn_body(q + m0 * 768 + h * 96, kv + kvrow0 * 1024 + h * 128, kr + kvrow0 * 32, kv + kvrow0 * 1024 + h * 128 + 64, mix + m0 * 1024 + h * 64, seq, lds);
  }
}


#define XB_TMO      128
#define XB_XCNT(j)  (256  + 64 * (j))
#define XB_XSUB(j)  (1280 + 64 * (j))
#define XB_XGEN(j)  (2304 + 64 * (j))
#define XB_TOP      3328
#define XB_TOPGEN   3392
#define XCD_BAR_WORDS 3456
#define XB_SPIN_CAP (1u << 18)
#define LAS __attribute__((address_space(3)))
__device__ __forceinline__ unsigned xb_ld(unsigned* p)              { return __hip_atomic_load(p, __ATOMIC_RELAXED, __HIP_MEMORY_SCOPE_AGENT); }
__device__ __forceinline__ unsigned xb_add(unsigned* p, unsigned v) { return __hip_atomic_fetch_add(p, v, __ATOMIC_RELAXED, __HIP_MEMORY_SCOPE_AGENT); }
__device__ __forceinline__ unsigned xb_xcc_id() { return (unsigned)__builtin_amdgcn_s_getreg((3 << 11) | 20) & 0xFu; }
#define XB_SPIN(cond, bar) do { unsigned _sp = 0; while (cond) { __builtin_amdgcn_s_sleep(1); \
    if ((++_sp & 255u) == 0u) { if (xb_ld(&(bar)[XB_TMO])) break; if (_sp > XB_SPIN_CAP) { atomicAdd(&(bar)[XB_TMO], 1u); break; } } } } while (0)
struct XcdBarrier { unsigned* bar; unsigned x; volatile LAS unsigned* st; };
__device__ __forceinline__ XcdBarrier xcd_barrier_post(unsigned* bar, volatile LAS unsigned* st) {
  XcdBarrier b; b.bar = bar; b.x = (unsigned)__builtin_amdgcn_readfirstlane((int)xb_xcc_id()); b.st = st;
  if (threadIdx.x == 0) (void)xb_add(&bar[XB_XCNT(b.x)], 1u);
  return b;
}
__device__ __forceinline__ void xcd_barrier_complete(unsigned* bar, unsigned x, unsigned& nloc, unsigned& nx) {
  const unsigned G = gridDim.x * gridDim.y * gridDim.z;
  unsigned sum, cnt, mine, sp = 0u;
  for (;;) {
    sum = 0u; cnt = 0u; mine = 0u;
#pragma unroll
    for (unsigned j = 0; j < 16; ++j) { const unsigned c = xb_ld(&bar[XB_XCNT(j)]); sum += c; cnt += (c > 0u) ? 1u : 0u; mine = (j == x) ? c : mine; }
    if (sum == G) break;
    __builtin_amdgcn_s_sleep(1);
    if ((++sp & 255u) == 0u) { if (xb_ld(&bar[XB_TMO])) break; if (sp > XB_SPIN_CAP) { atomicAdd(&bar[XB_TMO], 1u); break; } }
  }
  nloc = mine > 0u ? mine : 1u; nx = cnt > 0u ? cnt : 1u;
}
__device__ __forceinline__ void xcd_barrier(const XcdBarrier& b) {
  asm volatile("s_waitcnt vmcnt(0)" ::: "memory");
  __syncthreads();
  if (threadIdx.x == 0) {
    unsigned* bar = b.bar; asm volatile("" : "+s"(bar));
    unsigned bx = b.x; asm volatile("" : "+s"(bx));
    __builtin_amdgcn_s_waitcnt(0);
    unsigned nloc = b.st[0], nx = b.st[1];
    if (nloc == 0u) { xcd_barrier_complete(bar, bx, nloc, nx); b.st[0] = nloc; b.st[1] = nx; }
    const unsigned old = xb_add(&bar[XB_XSUB(bx)], 1u);
    const unsigned gen = old / nloc;
    if (old + 1u == (gen + 1u) * nloc) {
      __builtin_amdgcn_fence(__ATOMIC_RELEASE, "agent");
      asm volatile("s_waitcnt vmcnt(0)" ::: "memory");
      const unsigned og = xb_add(&bar[XB_TOP], 1u);
      const unsigned tg = og / nx;
      if (og + 1u == (tg + 1u) * nx) xb_add(&bar[XB_TOPGEN], 1u);
      else XB_SPIN(xb_ld(&bar[XB_TOPGEN]) == tg, bar);
      __builtin_amdgcn_fence(__ATOMIC_ACQUIRE, "agent");
      xb_add(&bar[XB_XGEN(bx)], 1u);
      asm volatile("s_waitcnt vmcnt(0)" ::: "memory");
    } else {
      XB_SPIN(xb_ld(&bar[XB_XGEN(bx)]) == gen, bar);
      __builtin_amdgcn_fence(__ATOMIC_ACQUIRE, "agent");
      asm volatile("s_waitcnt vmcnt(0)" ::: "memory");
    }
  }
  __syncthreads();
}
#define GSYNC() xcd_barrier(xb)

#ifndef STOP_AT
#define STOP_AT 0
#endif
__device__ __forceinline__ void phase_dump(const Params& p, const u16* buf, size_t count, int isf32) {
  const size_t n = 44564480;
  for (size_t i = (size_t)blockIdx.x * NTHR + threadIdx.x; i < n; i += (size_t)gridDim.x * NTHR) {
    float v = 0.f;
    if (i < count) v = isf32 ? ((const float*)buf)[i] : bf2f(buf[i]);
    if (!(fabsf(v) < 1e30f)) v = 7777.f;
    p.out[i] = v;
  }
}
#define STOP(k, buf, count, isf32) do { if (STOP_AT == (k)) { GSYNC(); phase_dump(p, (const u16*)(buf), (count), (isf32)); return; } } while (0)
__global__ void __launch_bounds__(NTHR) fwd_megakernel(Params p) {
  extern __shared__ __attribute__((aligned(16))) char lds[];
  cg::grid_group grid = cg::this_grid();
  if (p.out == nullptr) grid.sync();
  volatile LAS unsigned* xst = (volatile LAS unsigned*)(lds + LDS_MAIN);
  if (threadIdx.x == 0) { xst[0] = 0u; xst[1] = 0u; }
  __syncthreads();
  XcdBarrier xb = xcd_barrier_post((unsigned*)(p.ws + OFF_BAR), xst);
  phase_prep(p, lds);
  STOP(1, p.ws + OFF_W, (OFF_TAB + 4096) / 2, 0);
  GSYNC();
  phase_rows(p, 0, 0);
  STOP(2, p.ws + OFF_C, (size_t)M_TOK * 1024, 0);
  GSYNC();
  for (int lv = 0; lv < DEPTH; ++lv) {
    int l = lv; asm volatile("" : "+s"(l));
    phase_gemm_in(p, l, lds);
    STOP(3, p.ws + A_PROJ, (size_t)M_TOK * IN_COLS, 0);
    GSYNC();
    phase_mid(p, l, lds);
    STOP(4, p.ws + A_QAN, (A_END - A_QAN) / 2, 0);
    GSYNC();
    phase_gemm_mix(p, l, lds);
    STOP(5, p.ws + B_Q, (B_END - B_Q) / 2, 0);
    GSYNC();
    phase_attn(p, lds);
    STOP(6, p.ws + OFF_C, (size_t)M_TOK * 1024, 0);
    GSYNC();
    phase_gemm_f32out(p, OFF_C, 1024, OFF_W + (size_t)l * WL_SIZE + WL_OUT, lds);
    STOP(7, p.ws + OFF_B, (size_t)M_TOK * 1024, 1);
    GSYNC();
    phase_rows(p, 1, l);
    STOP(8, p.ws + OFF_C, (size_t)M_TOK * 1024, 0);
    GSYNC();
    phase_gemm_up(p, l, lds);
    STOP(9, p.ws + OFF_A, (size_t)M_TOK * DFF, 0);
    GSYNC();
    phase_fixup(p, l);
    STOP(10, p.ws + OFF_A, (size_t)M_TOK * DFF, 0);
    GSYNC();
    phase_gemm_f32out(p, OFF_A, DFF, OFF_W + (size_t)l * WL_SIZE + WL_DOWN, lds);
    STOP(11, p.ws + OFF_B, (size_t)M_TOK * 1024, 1);
    GSYNC();
    phase_rows(p, 2, l);
    if (l + 1 < DEPTH) GSYNC();
  }
}

extern "C" void kernel_launch(void* const* d_in, const int* in_sizes, int n_in, void* d_out, int out_size, void* d_ws, size_t ws_size,
                              hipStream_t stream) {
  static int grid_blocks = 0;
  if (!grid_blocks) {
    if (n_in != 27 || ws_size < WS_END) { fprintf(stderr, "kernel_launch: bad n_in %d or ws_size %zu < %zu\n", n_in, ws_size, (size_t)WS_END); return; }
    if (hipFuncSetAttribute((const void*)fwd_megakernel, hipFuncAttributeMaxDynamicSharedMemorySize, LDS_BYTES) != hipSuccess) {
      fprintf(stderr, "kernel_launch: hipFuncSetAttribute failed\n"); return; }
    int dev = 0, cus = 0, per_cu = 0;
    hipGetDevice(&dev);
    hipDeviceGetAttribute(&cus, hipDeviceAttributeMultiprocessorCount, dev);
    hipOccupancyMaxActiveBlocksPerMultiprocessor(&per_cu, fwd_megakernel, NTHR, LDS_BYTES);
    if (per_cu < 1) { fprintf(stderr, "kernel_launch: occupancy 0\n"); return; }
    grid_blocks = cus;
  }
  Params p{};
  const float** pp = (const float**)&p;
  for (int i = 0; i < 27; ++i) pp[i] = (const float*)d_in[i];
  p.out = (float*)d_out;
  p.ws = (char*)d_ws;
  hipMemsetAsync((char*)d_ws + OFF_BAR, 0, XCD_BAR_WORDS * 4, stream);
  void* args[] = {&p};
  hipError_t e = hipLaunchCooperativeKernel((void*)fwd_megakernel, dim3(grid_blocks), dim3(NTHR), args, LDS_BYTES, stream);
  if (e != hipSuccess) fprintf(stderr, "cooperative launch failed: %s (grid %d)\n", hipGetErrorString(e), grid_blocks);
}
```

```cpp
#include <hip/hip_runtime.h>
#include <hip/hip_cooperative_groups.h>
#include <cstdio>
#include <cstdint>
namespace cg = cooperative_groups;

typedef unsigned short u16;
using bf16x8 = __attribute__((ext_vector_type(8))) short;
using s16x4  = __attribute__((ext_vector_type(4))) short;
using f32x16 = __attribute__((ext_vector_type(16))) float;
using u32x4  = __attribute__((ext_vector_type(4))) unsigned;
using u32x2  = __attribute__((ext_vector_type(2))) unsigned;

constexpr int DM = 1024, DEPTH = 2;
constexpr int M_CTX = 8192, M_LAT = 32768, M_TOK = 40960;
constexpr int S_CTX = 256, S_LAT = 4096, PAST = 512, T_LAT = 4608;
constexpr int KV_ROWS = M_CTX + 8 * T_LAT;
constexpr int IN_COLS = 1184, IN_PAD = 1280;
constexpr int DFF = 2816;
constexpr float EPS = 1e-6f;
constexpr int NTHR = 512;

constexpr size_t WL_IN = 0;
constexpr size_t WL_QB = WL_IN + (size_t)IN_PAD * 1024 * 2;
constexpr size_t WL_KVB = WL_QB + (size_t)768 * 256 * 2;
constexpr size_t WL_POOL = WL_KVB + (size_t)1024 * 128 * 2;
constexpr size_t WL_SGU = WL_POOL + (size_t)256 * 256 * 2;
constexpr size_t WL_OUT = WL_SGU + (size_t)4 * 128 * 128 * 2;
constexpr size_t WL_UP = WL_OUT + (size_t)1024 * 1024 * 2;
constexpr size_t WL_DOWN = WL_UP + (size_t)5632 * 1024 * 2;
constexpr size_t WL_SIZE = WL_DOWN + (size_t)1024 * 2816 * 2;
constexpr size_t OFF_W = 0;
constexpr size_t OFF_MOD = OFF_W + 2 * WL_SIZE;
constexpr size_t OFF_TAB = OFF_MOD + (size_t)2 * 9 * 6144 * 4;
constexpr size_t OFF_BAR = OFF_TAB + 4096;
constexpr size_t OFF_C = OFF_BAR + 16384;
constexpr size_t OFF_A = OFF_C + (size_t)M_TOK * 1024 * 2;
constexpr size_t A_PROJ = OFF_A;
constexpr size_t A_QAN = A_PROJ + (size_t)M_TOK * IN_COLS * 2;
constexpr size_t A_CKV = A_QAN + (size_t)M_TOK * 256 * 2;
constexpr size_t A_DPOOL = A_CKV + (size_t)KV_ROWS * 128 * 2;
constexpr size_t A_VT = A_DPOOL + (size_t)M_TOK * 256 * 2;
constexpr size_t A_END = A_VT + (size_t)M_TOK * 256 * 2;
constexpr size_t OFF_B = OFF_A + (size_t)M_TOK * DFF * 2;
static_assert(A_END <= OFF_B, "region A overflow");
constexpr size_t B_Q = OFF_B;
constexpr size_t B_KV = B_Q + (size_t)M_TOK * 768 * 2;
constexpr size_t B_KR = B_KV + (size_t)KV_ROWS * 1024 * 2;
constexpr size_t B_END = B_KR + (size_t)KV_ROWS * 32 * 2;
constexpr size_t WS_END = OFF_B + (size_t)M_TOK * 1024 * 4;
static_assert(B_END <= WS_END, "region B overflow");

constexpr size_t OUT_CKV = (size_t)M_TOK * 1024;
constexpr size_t OUT_KR = OUT_CKV + (size_t)32 * 2 * 256 * 128;

constexpr int LDS_MAIN = 135168;
constexpr int LDS_BYTES = LDS_MAIN + 16;

struct Params {
  const float *x_prompt, *x_sample, *cache_ckv, *cache_krope, *c, *c_ctx, *w_mod, *b_mod,
      *g_pre_mix, *g_post_mix, *g_pre_ffn, *g_post_ffn, *w_in, *g_q_a, *w_q_b, *g_kv_a, *w_kv_b,
      *w_pool, *pool_scale, *g_sgu, *w_sgu, *b_sgu, *w_out, *w_up, *conv_w, *conv_b, *w_down;
  float* out;
  char* ws;
};

typedef float f32x2_t __attribute__((ext_vector_type(2)));
typedef __bf16 bf16x2_t __attribute__((ext_vector_type(2)));
__device__ __forceinline__ unsigned cvtpk(float lo, float hi) {
  f32x2_t v = {lo, hi};
  bf16x2_t r = __builtin_convertvector(v, bf16x2_t);
  return __builtin_bit_cast(unsigned, r);
}
__device__ __forceinline__ u16 f2bf(float x) { return (u16)(cvtpk(x, 0.f) & 0xffffu); }
__device__ __forceinline__ float bf2f(u16 b) { return __uint_as_float(((unsigned)b) << 16); }
__device__ __forceinline__ float bflo(unsigned w) { return __uint_as_float(w << 16); }
__device__ __forceinline__ float bfhi(unsigned w) { return __uint_as_float(w & 0xffff0000u); }
__device__ __forceinline__ float wave_sum(float v) {
  v += __int_as_float(__builtin_amdgcn_mov_dpp(__float_as_int(v), 0xB1, 0xF, 0xF, true));
  v += __int_as_float(__builtin_amdgcn_mov_dpp(__float_as_int(v), 0x4E, 0xF, 0xF, true));
  v += __int_as_float(__builtin_amdgcn_mov_dpp(__float_as_int(v), 0x124, 0xF, 0xF, true));
  v += __int_as_float(__builtin_amdgcn_mov_dpp(__float_as_int(v), 0x128, 0xF, 0xF, true));
  v += __shfl_xor(v, 16);
  v += __shfl_xor(v, 32);
  return v;
}
__device__ __forceinline__ int opaque_tid() { int t = threadIdx.x; asm volatile("" : "+v"(t)); return t; }
__device__ __forceinline__ int crow(int r, int hi) { return (r & 3) + 8 * (r >> 2) + 4 * hi; }
__device__ __forceinline__ float silu_f(float x) { return x * __builtin_amdgcn_rcpf(1.f + __builtin_amdgcn_exp2f(-1.4426950408889634f * x)); }

#define KARG __attribute__((address_space(4)))
#define PHASE_PARAMS const KARG char* kp_ = (const KARG char*)__builtin_amdgcn_kernarg_segment_ptr(); asm volatile("" : "+s"(kp_)); Params p; \
  p.x_prompt = *(const float* const KARG*)(kp_ + 0); \
  p.x_sample = *(const float* const KARG*)(kp_ + 8); \
  p.cache_ckv = *(const float* const KARG*)(kp_ + 16); \
  p.cache_krope = *(const float* const KARG*)(kp_ + 24); \
  p.c = *(const float* const KARG*)(kp_ + 32); \
  p.c_ctx = *(const float* const KARG*)(kp_ + 40); \
  p.w_mod = *(const float* const KARG*)(kp_ + 48); \
  p.b_mod = *(const float* const KARG*)(kp_ + 56); \
  p.g_pre_mix = *(const float* const KARG*)(kp_ + 64); \
  p.g_post_mix = *(const float* const KARG*)(kp_ + 72); \
  p.g_pre_ffn = *(const float* const KARG*)(kp_ + 80); \
  p.g_post_ffn = *(const float* const KARG*)(kp_ + 88); \
  p.w_in = *(const float* const KARG*)(kp_ + 96); \
  p.g_q_a = *(const float* const KARG*)(kp_ + 104); \
  p.w_q_b = *(const float* const KARG*)(kp_ + 112); \
  p.g_kv_a = *(const float* const KARG*)(kp_ + 120); \
  p.w_kv_b = *(const float* const KARG*)(kp_ + 128); \
  p.w_pool = *(const float* const KARG*)(kp_ + 136); \
  p.pool_scale = *(const float* const KARG*)(kp_ + 144); \
  p.g_sgu = *(const float* const KARG*)(kp_ + 152); \
  p.w_sgu = *(const float* const KARG*)(kp_ + 160); \
  p.b_sgu = *(const float* const KARG*)(kp_ + 168); \
  p.w_out = *(const float* const KARG*)(kp_ + 176); \
  p.w_up = *(const float* const KARG*)(kp_ + 184); \
  p.conv_w = *(const float* const KARG*)(kp_ + 192); \
  p.conv_b = *(const float* const KARG*)(kp_ + 200); \
  p.w_down = *(const float* const KARG*)(kp_ + 208); \
  p.out = *(float* const KARG*)(kp_ + 216); p.ws = *(char* const KARG*)(kp_ + 224)
__device__ __forceinline__ void cvt_tile_T(const float* __restrict__ src, int ld_src, u16* __restrict__ dst, int K, int kt, int nt, int mode,
                           int Nvalid, float* t) {
  const int tid = opaque_tid();
  const int k0 = kt * 64, n0 = nt * 128;
  {
    const int n = n0 + (tid & 127);
    int sc; bool valid;
    if (mode == 1) { const int t256 = n >> 8, wn = (n >> 6) & 3, blk = (n >> 5) & 1, c = n & 31; sc = blk * DFF + t256 * 128 + wn * 32 + c; valid = true; }
    else { sc = n; valid = n < Nvalid; }
    float v[16];
#pragma unroll
    for (int i = 0; i < 16; ++i) { const int k = (tid >> 7) + 4 * i; v[i] = valid ? src[(long)(k0 + k) * ld_src + sc] : 0.f; }
#pragma unroll
    for (int i = 0; i < 16; ++i) { const int k = (tid >> 7) + 4 * i; t[k * 129 + (tid & 127)] = v[i]; }
  }
  __syncthreads();
  {
    const int n = tid >> 2, kc = tid & 3;
    float v[16];
#pragma unroll
    for (int j = 0; j < 16; ++j) v[j] = t[(kc * 16 + j) * 129 + n];
    u32x4 w0 = {cvtpk(v[0], v[1]), cvtpk(v[2], v[3]), cvtpk(v[4], v[5]), cvtpk(v[6], v[7])};
    u32x4 w1 = {cvtpk(v[8], v[9]), cvtpk(v[10], v[11]), cvtpk(v[12], v[13]), cvtpk(v[14], v[15])};
    u16* d = dst + (long)(n0 + n) * K + k0 + kc * 16;
    *(u32x4*)d = w0; *(u32x4*)(d + 8) = w1;
  }
  __syncthreads();
}

__device__ __forceinline__ void mod_job(const Params& p, int l, int nt64, float* lds) {
  char* wsb = p.ws; asm volatile("" : "+s"(wsb));
  const int tid = opaque_tid();
  float* sc = lds; float* red = lds + 9216;
  for (int idx = tid; idx < 9216; idx += NTHR) {
    const int r = idx >> 10, k = idx & 1023;
    const float x = (r == 0) ? p.c_ctx[k] : p.c[(r - 1) * 1024 + k];
    sc[idx] = x / (1.f + expf(-x));
  }
  __syncthreads();
  const int kq = tid >> 6, cc = tid & 63, n = nt64 * 64 + cc;
  float acc[9];
#pragma unroll
  for (int r = 0; r < 9; ++r) acc[r] = 0.f;
  const float* wp = p.w_mod + ((long)l * 1024 + kq * 128) * 6144 + n;
#pragma unroll 32
  for (int kk = 0; kk < 128; ++kk) {
    const float w = wp[(long)kk * 6144];
    const int k = kq * 128 + kk;
#pragma unroll
    for (int r = 0; r < 9; ++r) acc[r] = fmaf(sc[r * 1024 + k], w, acc[r]);
  }
#pragma unroll
  for (int r = 0; r < 9; ++r) red[(kq * 9 + r) * 64 + cc] = acc[r];
  __syncthreads();
  float* mod = (float*)(wsb + OFF_MOD);
  for (int idx = tid; idx < 576; idx += NTHR) {
    const int r = idx >> 6, c2 = idx & 63, n2 = nt64 * 64 + c2;
    float s = p.b_mod[l * 6144 + n2];
#pragma unroll
    for (int q = 0; q < 8; ++q) s += red[(q * 9 + r) * 64 + c2];
    mod[(l * 9 + r) * 6144 + n2] = s;
  }
  __syncthreads();
}

__device__ __forceinline__ void phase_prep(const Params& p_unused_, char* lds) {
  PHASE_PARAMS;
  char* wsb = p.ws; asm volatile("" : "+s"(wsb));
  const int tid = opaque_tid();
  constexpr int PER_L = 1416;
  constexpr int NJOBS = 193 + 2 * PER_L;
  for (int job = blockIdx.x; job < NJOBS; job += gridDim.x) {
    if (job < 192) { mod_job(p, job / 96, job % 96, (float*)lds); continue; }
    if (job == 192) {
      float2* tab = (float2*)(wsb + OFF_TAB);
      const int pos = tid >> 3, f = tid & 7;
      const float freq = powf(10000.f, -(float)f / 8.f);
      const float ang = (float)pos * freq;
      tab[tid] = make_float2(cosf(ang), sinf(ang));
      continue;
    }
    int j = job - 193; const int l = j / PER_L; j -= l * PER_L;
    char* wl = wsb + OFF_W + (size_t)l * WL_SIZE;
    float* t = (float*)lds;
    if (j < 160) { cvt_tile_T(p.w_in + (size_t)l * 1024 * IN_COLS, IN_COLS, (u16*)(wl + WL_IN), 1024, j / 10, j % 10, 0, IN_COLS, t); continue; }
    j -= 160;
    if (j < 24) { cvt_tile_T(p.w_q_b + (size_t)l * 256 * 768, 768, (u16*)(wl + WL_QB), 256, j / 6, j % 6, 0, 768, t); continue; }
    j -= 24;
    if (j < 16) { cvt_tile_T(p.w_kv_b + (size_t)l * 128 * 1024, 1024, (u16*)(wl + WL_KVB), 128, j / 8, j % 8, 0, 1024, t); continue; }
    j -= 16;
    if (j < 128) { cvt_tile_T(p.w_out + (size_t)l * 1024 * 1024, 1024, (u16*)(wl + WL_OUT), 1024, j / 8, j % 8, 0, 1024, t); continue; }
    j -= 128;
    if (j < 704) { cvt_tile_T(p.w_up + (size_t)l * 1024 * 5632, 5632, (u16*)(wl + WL_UP), 1024, j / 44, j % 44, 1, 5632, t); continue; }
    j -= 704;
    if (j < 352) { cvt_tile_T(p.w_down + (size_t)l * 2816 * 1024, 1024, (u16*)(wl + WL_DOWN), 2816, j / 8, j % 8, 0, 1024, t); continue; }
    j -= 352;
    if (j < 16) {
      u16* dst = (u16*)(wl + WL_POOL);
      for (int i = 0; i < 8; ++i) {
        const int idx = j * 4096 + i * 512 + tid; const int n = idx >> 8, k = idx & 255;
        const int g = n >> 6, e = n & 63, g2 = k >> 6, c = k & 63;
        dst[idx] = (g == g2) ? f2bf(p.w_pool[(((size_t)l * 4 + g) * 64 + c) * 64 + e]) : (u16)0;
      }
      continue;
    }
    j -= 16;
    {
      u16* dst = (u16*)(wl + WL_SGU);
      for (int i = 0; i < 8; ++i) { const int idx = j * 4096 + i * 512 + tid; dst[idx] = f2bf(p.w_sgu[(size_t)l * 65536 + idx]); }
    }
  }
}

__device__ __forceinline__ void phase_rows(const Params& p_unused_, int mode, int l) {
  PHASE_PARAMS;
  char* wsb = p.ws; asm volatile("" : "+s"(wsb));
  const int tid = opaque_tid(), wid = tid >> 6, lane = tid & 63;
  const float* mod = (const float*)(wsb + OFF_MOD);
  const u16* obuf = (const u16*)(wsb + OFF_B);
  u16* hbuf = (u16*)(wsb + OFF_C);
  u16* x1buf = (u16*)(wsb + OFF_B + (size_t)M_TOK * 1024 * 2);
  u16* x2buf = (u16*)p.out;
  const bool from_in = (mode == 0 || (mode == 1 && l == 0));
  const bool final_out = (mode == 2 && l + 1 >= DEPTH);
  const u16* xsrc = (mode == 1) ? x2buf : x1buf;
  u16* xdst = (mode == 1) ? x1buf : x2buf;
  const int stride = gridDim.x * 8;
  float4 xn[2][4]; u32x2 xbn[2][4]; u32x2 on[2][4];
#define ROW_LOAD(k, mm) do { const int m_ = (mm); \
    if (from_in) { const float* xs_ = (m_ < M_CTX) ? p.x_prompt + (size_t)m_ * 1024 : p.x_sample + (size_t)(m_ - M_CTX) * 1024; \
      _Pragma("unroll") for (int i = 0; i < 4; ++i) xn[k][i] = *(const float4*)(xs_ + i * 256 + lane * 4); } \
    else { _Pragma("unroll") for (int i = 0; i < 4; ++i) xbn[k][i] = *(const u32x2*)(xsrc + (size_t)m_ * 1024 + i * 256 + lane * 4); } \
    if (mode != 0) { _Pragma("unroll") for (int i = 0; i < 4; ++i) on[k][i] = *(const u32x2*)(obuf + (size_t)m_ * 1024 + i * 256 + lane * 4); } } while (0)
  const int per = (((M_TOK + stride - 1) / stride) + 1) & ~1;
  int m = (blockIdx.x * 8 + wid) * per;
  const int mend = min(m + per, M_TOK);
  if (m < mend) { ROW_LOAD(0, m); ROW_LOAD(1, m + 1); }
  const int step = 2;
  const int nk = 2;
  const int lh_ = (mode == 2) ? l + 1 : l;
  float4 c_gp[4], c_gpre[4], c_gate[4], c_shift[4], c_scale[4];
  {
    const float* gp_ = ((mode == 1) ? p.g_post_mix : p.g_post_ffn) + l * 1024;
    const float* gpre_ = ((mode == 1) ? p.g_pre_ffn : p.g_pre_mix) + (final_out ? l : lh_) * 1024;
#pragma unroll
    for (int i = 0; i < 4; ++i) { c_gp[i] = *(const float4*)(gp_ + i * 256 + lane * 4); c_gpre[i] = *(const float4*)(gpre_ + i * 256 + lane * 4); }
  }
  int rcur = -1;
  for (; m < mend; m += step) {
    {
      const int rnew = (m < M_CTX) ? 0 : 1 + ((m - M_CTX) >> 12);
      if (rnew != rcur) {
        rcur = rnew;
        const float* gate_ = mod + ((size_t)l * 9 + rnew) * 6144 + ((mode == 1) ? 2 : 5) * 1024;
        const float* modh_ = mod + ((size_t)(final_out ? l : lh_) * 9 + rnew) * 6144;
        const float* shift_ = modh_ + ((mode == 1) ? 3 : 0) * 1024;
        const float* scale_ = modh_ + ((mode == 1) ? 4 : 1) * 1024;
#pragma unroll
        for (int i = 0; i < 4; ++i) {
          c_gate[i] = *(const float4*)(gate_ + i * 256 + lane * 4);
          c_shift[i] = *(const float4*)(shift_ + i * 256 + lane * 4);
          c_scale[i] = *(const float4*)(scale_ + i * 256 + lane * 4);
        }
      }
    }
    float4 x[2][4]; u32x2 ow[2][4];
#pragma unroll
    for (int k = 0; k < 2; ++k)
#pragma unroll
      for (int i = 0; i < 4; ++i) {
        x[k][i] = from_in ? xn[k][i] : make_float4(bflo(xbn[k][i][0]), bfhi(xbn[k][i][0]), bflo(xbn[k][i][1]), bfhi(xbn[k][i][1]));
        ow[k][i] = on[k][i];
      }
    if (m + step < mend) { ROW_LOAD(0, m + step); ROW_LOAD(1, m + step + 1); }
    float rstd_o[2], rstd_x[2];
    int rr[2];
#pragma unroll
    for (int k = 0; k < 2; ++k) { const int mk = m + k; rr[k] = (mk < M_CTX) ? 0 : 1 + ((mk - M_CTX) >> 12); }
    if (mode != 0) {
      float ss[2];
#pragma unroll
      for (int k = 0; k < 2; ++k) {
        ss[k] = 0.f;
#pragma unroll
        for (int i = 0; i < 4; ++i) { const float a = bflo(ow[k][i][0]), b = bfhi(ow[k][i][0]), c = bflo(ow[k][i][1]), d = bfhi(ow[k][i][1]); ss[k] += a * a + b * b + c * c + d * d; }
      }
      ss[0] = wave_sum(ss[0]); ss[1] = wave_sum(ss[1]);
      rstd_o[0] = rsqrtf(ss[0] * (1.f / 1024.f) + EPS); rstd_o[1] = rsqrtf(ss[1] * (1.f / 1024.f) + EPS);
      const float* gp = ((mode == 1) ? p.g_post_mix : p.g_post_ffn) + l * 1024;
#pragma unroll
      for (int k = 0; k < 2; ++k) {
        if (k >= nk) break;
        const int mk = m + k;
        const float* gate = mod + ((size_t)l * 9 + rr[k]) * 6144 + ((mode == 1) ? 2 : 5) * 1024;
#pragma unroll
        for (int i = 0; i < 4; ++i) {
          const int c = i * 256 + lane * 4;
          const float4 g = c_gp[i], gt = c_gate[i];
          x[k][i].x += gt.x * (bflo(ow[k][i][0]) * rstd_o[k] * g.x); x[k][i].y += gt.y * (bfhi(ow[k][i][0]) * rstd_o[k] * g.y);
          x[k][i].z += gt.z * (bflo(ow[k][i][1]) * rstd_o[k] * g.z); x[k][i].w += gt.w * (bfhi(ow[k][i][1]) * rstd_o[k] * g.w);
          if (final_out) *(float4*)(p.out + (size_t)mk * 1024 + c) = x[k][i];
          else { u32x2 w = {cvtpk(x[k][i].x, x[k][i].y), cvtpk(x[k][i].z, x[k][i].w)}; *(u32x2*)(xdst + (size_t)mk * 1024 + c) = w; }
        }
      }
    }
    if (final_out) continue;
    const int lh = (mode == 2) ? l + 1 : l;
    const float* gpre = ((mode == 1) ? p.g_pre_ffn : p.g_pre_mix) + lh * 1024;
    {
      float ss[2];
#pragma unroll
      for (int k = 0; k < 2; ++k) {
        ss[k] = 0.f;
#pragma unroll
        for (int i = 0; i < 4; ++i) ss[k] += x[k][i].x * x[k][i].x + x[k][i].y * x[k][i].y + x[k][i].z * x[k][i].z + x[k][i].w * x[k][i].w;
      }
      ss[0] = wave_sum(ss[0]); ss[1] = wave_sum(ss[1]);
      rstd_x[0] = rsqrtf(ss[0] * (1.f / 1024.f) + EPS); rstd_x[1] = rsqrtf(ss[1] * (1.f / 1024.f) + EPS);
    }
#pragma unroll
    for (int k = 0; k < 2; ++k) {
      if (k >= nk) break;
      const int mk = m + k;
      const float* modh = mod + ((size_t)lh * 9 + rr[k]) * 6144;
      const float* shift = modh + ((mode == 1) ? 3 : 0) * 1024;
      const float* scale = modh + ((mode == 1) ? 4 : 1) * 1024;
#pragma unroll
      for (int i = 0; i < 4; ++i) {
        const int c = i * 256 + lane * 4;
        const float4 g = c_gpre[i], sh = c_shift[i], sc = c_scale[i];
        const float h0 = x[k][i].x * rstd_x[k] * g.x * (1.f + sc.x) + sh.x, h1 = x[k][i].y * rstd_x[k] * g.y * (1.f + sc.y) + sh.y;
        const float h2 = x[k][i].z * rstd_x[k] * g.z * (1.f + sc.z) + sh.z, h3 = x[k][i].w * rstd_x[k] * g.w * (1.f + sc.w) + sh.w;
        u32x2 w = {cvtpk(h0, h1), cvtpk(h2, h3)};
        *(u32x2*)(hbuf + (size_t)mk * 1024 + c) = w;
      }
    }
  }
#undef ROW_LOAD
}

__device__ __forceinline__ void gemm_mainloop(const u16* __restrict__ A, int lda, const u16* __restrict__ Bt, int ldb, int K, char* lds,
                                              f32x16 (&acc)[2][2], const int tid) {
  const int wid = tid >> 6, lane = tid & 63, r32 = lane & 31, hi = lane >> 5, wm = wid >> 1, wn = wid & 1;
  const int lrow = tid >> 3, lch = tid & 7;
  const u16* ag = A + (long)lrow * lda + lch * 8;
  const u16* bg = Bt + (long)lrow * ldb + lch * 8;
  const int woff = lrow * 128 + ((lch ^ ((lrow >> 1) & 7)) << 4);
  const int arow = wm * 64 + r32, asw = (arow >> 1) & 7;
  const int brow = wn * 64 + r32, bsw = (brow >> 1) & 7;
  u32x4 ra0[4], rb0[2], ra1[4], rb1[2];
#define GLOAD(kt, RA, RB) do { _Pragma("unroll") for (int i = 0; i < 4; ++i) RA[i] = *(const u32x4*)(ag + (long)(64 * i) * lda + (kt) * 64); \
    _Pragma("unroll") for (int i = 0; i < 2; ++i) RB[i] = *(const u32x4*)(bg + (long)(64 * i) * ldb + (kt) * 64); } while (0)
#define LWRITE(buf, RA, RB) do { _Pragma("unroll") for (int i = 0; i < 4; ++i) *(u32x4*)(lds + (buf) * 32768 + woff + i * 8192) = RA[i]; \
    _Pragma("unroll") for (int i = 0; i < 2; ++i) *(u32x4*)(lds + 65536 + (buf) * 16384 + woff + i * 8192) = RB[i]; } while (0)
#define COMPUTE(buf) do { const char* As = lds + (buf) * 32768; const char* Bs = lds + 65536 + (buf) * 16384; \
    _Pragma("unroll") for (int ks = 0; ks < 4; ++ks) { \
      const bf16x8 a0 = *(const bf16x8*)(As + arow * 128 + (((ks * 2 + hi) ^ asw) << 4)); \
      const bf16x8 a1 = *(const bf16x8*)(As + (arow + 32) * 128 + (((ks * 2 + hi) ^ asw) << 4)); \
      const bf16x8 b0 = *(const bf16x8*)(Bs + brow * 128 + (((ks * 2 + hi) ^ bsw) << 4)); \
      const bf16x8 b1 = *(const bf16x8*)(Bs + (brow + 32) * 128 + (((ks * 2 + hi) ^ bsw) << 4)); \
      acc[0][0] = __builtin_amdgcn_mfma_f32_32x32x16_bf16(a0, b0, acc[0][0], 0, 0, 0); \
      acc[0][1] = __builtin_amdgcn_mfma_f32_32x32x16_bf16(a0, b1, acc[0][1], 0, 0, 0); \
      acc[1][0] = __builtin_amdgcn_mfma_f32_32x32x16_bf16(a1, b0, acc[1][0], 0, 0, 0); \
      acc[1][1] = __builtin_amdgcn_mfma_f32_32x32x16_bf16(a1, b1, acc[1][1], 0, 0, 0); } } while (0)
#pragma unroll
  for (int a = 0; a < 2; ++a)
#pragma unroll
    for (int b = 0; b < 2; ++b)
#pragma unroll
      for (int r = 0; r < 16; ++r) acc[a][b][r] = 0.f;
  const int nt = K >> 6;
  GLOAD(0, ra0, rb0); GLOAD(1, ra1, rb1); LWRITE(0, ra0, rb0); __syncthreads();
  for (int kt = 0; kt < nt; kt += 2) {
    if (kt + 2 < nt) GLOAD(kt + 2, ra0, rb0);
    COMPUTE(0);
    LWRITE(1, ra1, rb1);
    __syncthreads();
    if (kt + 3 < nt) GLOAD(kt + 3, ra1, rb1);
    COMPUTE(1);
    if (kt + 2 < nt) LWRITE(0, ra0, rb0);
    __syncthreads();
  }
#undef GLOAD
#undef LWRITE
#undef COMPUTE
}

template <bool SWAP>
__device__ __forceinline__ void gemm256_mainloop(const u16* __restrict__ A, int lda, const u16* __restrict__ Bt, int ldb, int K, char* lds,
                                                 f32x16 (&acc)[4][2], const int tid) {
  const int wid = tid >> 6, lane = tid & 63, r32 = lane & 31, hi = lane >> 5, wm = wid >> 2, wn = wid & 3;
  const int srcch = (tid & 7) ^ ((tid >> 4) & 7);
  const u16* ag = A + (long)(tid >> 3) * lda + srcch * 8;
  const u16* bg = Bt + (long)(tid >> 3) * ldb + srcch * 8;
  const int swz = (r32 >> 1) & 7;
  const int aoff = (wm * 128 + r32) * 128, boff = (wn * 64 + r32) * 128;
#define ISSUE(kt, st) do { _Pragma("unroll") for (int i = 0; i < 4; ++i) { \
      __builtin_amdgcn_global_load_lds((const unsigned*)(ag + (long)(64 * i) * lda + (kt) * 64), (unsigned*)(lds + (st) * 65536 + tid * 16 + i * 8192), 16, 0, 0); \
      __builtin_amdgcn_global_load_lds((const unsigned*)(bg + (long)(64 * i) * ldb + (kt) * 64), (unsigned*)(lds + (st) * 65536 + 32768 + tid * 16 + i * 8192), 16, 0, 0); } } while (0)
#pragma unroll
  for (int a = 0; a < 4; ++a)
#pragma unroll
    for (int b = 0; b < 2; ++b)
#pragma unroll
      for (int r = 0; r < 16; ++r) acc[a][b][r] = 0.f;
  const int nt = K >> 6;
  ISSUE(0, 0);
  for (int kt = 0; kt < nt; ++kt) {
    const int st = kt & 1;
    asm volatile("s_waitcnt vmcnt(0)" ::: "memory");
    __syncthreads();
    if (kt + 1 < nt) ISSUE(kt + 1, st ^ 1);
    const char* As = lds + st * 65536 + aoff; const char* Bs = lds + st * 65536 + 32768 + boff;
    bf16x8 a0[4], b0[2], a1[4], b1[2];
#define FRAGS(ks, AF, BF) do { const int co = (((ks) * 2 + hi) ^ swz) << 4; \
      _Pragma("unroll") for (int mb = 0; mb < 4; ++mb) AF[mb] = *(const bf16x8*)(As + mb * 4096 + co); \
      _Pragma("unroll") for (int nb = 0; nb < 2; ++nb) BF[nb] = *(const bf16x8*)(Bs + nb * 4096 + co); } while (0)
#define MMAS(AF, BF) do { _Pragma("unroll") for (int mb = 0; mb < 4; ++mb) _Pragma("unroll") for (int nb = 0; nb < 2; ++nb) \
      acc[mb][nb] = SWAP ? __builtin_amdgcn_mfma_f32_32x32x16_bf16(BF[nb], AF[mb], acc[mb][nb], 0, 0, 0) \
                         : __builtin_amdgcn_mfma_f32_32x32x16_bf16(AF[mb], BF[nb], acc[mb][nb], 0, 0, 0); } while (0)
#define SB() __builtin_amdgcn_sched_barrier(0)
    FRAGS(0, a0, b0); SB();
    FRAGS(1, a1, b1); SB();
    MMAS(a0, b0); SB();
    FRAGS(2, a0, b0); SB();
    MMAS(a1, b1); SB();
    FRAGS(3, a1, b1); SB();
    MMAS(a0, b0); SB();
    MMAS(a1, b1); SB();
#undef FRAGS
#undef MMAS
#undef SB
  }
  __syncthreads();
#undef ISSUE
}

constexpr int G160_STAGE = 160 * 128 + 256 * 128;
__device__ __forceinline__ void gemm160_mainloop(const u16* __restrict__ A, int lda, const u16* __restrict__ Bt, int ldb, int K, char* lds,
                                                 f32x16 (&acc)[5], const int tid) {
  const int wid = tid >> 6, lane = tid & 63, r32 = lane & 31, hi = lane >> 5;
  const int srcch = (tid & 7) ^ ((tid >> 4) & 7);
  const u16* ag = A + (long)(tid >> 3) * lda + srcch * 8;
  const u16* bg = Bt + (long)(tid >> 3) * ldb + srcch * 8;
  const int swz = (r32 >> 1) & 7;
  const int aoff = r32 * 128, boff = 20480 + (wid * 32 + r32) * 128;
  const bool a3 = tid < 256;
#define ISSUE(kt, st) do { \
    _Pragma("unroll") for (int i = 0; i < 2; ++i) \
      __builtin_amdgcn_global_load_lds((const unsigned*)(ag + (long)(64 * i) * lda + (kt) * 64), (unsigned*)(lds + (st) * G160_STAGE + tid * 16 + i * 8192), 16, 0, 0); \
    if (a3) __builtin_amdgcn_global_load_lds((const unsigned*)(ag + (long)128 * lda + (kt) * 64), (unsigned*)(lds + (st) * G160_STAGE + tid * 16 + 16384), 16, 0, 0); \
    _Pragma("unroll") for (int i = 0; i < 4; ++i) \
      __builtin_amdgcn_global_load_lds((const unsigned*)(bg + (long)(64 * i) * ldb + (kt) * 64), (unsigned*)(lds + (st) * G160_STAGE + 20480 + tid * 16 + i * 8192), 16, 0, 0); } while (0)
#pragma unroll
  for (int a = 0; a < 5; ++a)
#pragma unroll
    for (int r = 0; r < 16; ++r) acc[a][r] = 0.f;
  const int nt = K >> 6;
  ISSUE(0, 0);
  for (int kt = 0; kt < nt; ++kt) {
    const int st = kt & 1;
    asm volatile("s_waitcnt vmcnt(0)" ::: "memory");
    __syncthreads();
    if (kt + 1 < nt) ISSUE(kt + 1, st ^ 1);
    const char* As = lds + st * G160_STAGE + aoff; const char* Bs = lds + st * G160_STAGE + boff;
    bf16x8 a0[5], b0, a1[5], b1;
#define FRAGS(ks, AF, BF) do { const int co = (((ks) * 2 + hi) ^ swz) << 4; \
      _Pragma("unroll") for (int mb = 0; mb < 5; ++mb) AF[mb] = *(const bf16x8*)(As + mb * 4096 + co); \
      BF = *(const bf16x8*)(Bs + co); } while (0)
#define MMAS(AF, BF) do { _Pragma("unroll") for (int mb = 0; mb < 5; ++mb) acc[mb] = __builtin_amdgcn_mfma_f32_32x32x16_bf16(BF, AF[mb], acc[mb], 0, 0, 0); } while (0)
#define SB() __builtin_amdgcn_sched_barrier(0)
    FRAGS(0, a0, b0); SB();
    FRAGS(1, a1, b1); SB();
    MMAS(a0, b0); SB();
    FRAGS(2, a0, b0); SB();
    MMAS(a1, b1); SB();
    FRAGS(3, a1, b1); SB();
    MMAS(a0, b0); SB();
    MMAS(a1, b1); SB();
#undef FRAGS
#undef MMAS
#undef SB
  }
  __syncthreads();
#undef ISSUE
}

using f32x4 = __attribute__((ext_vector_type(4))) float;
__device__ __forceinline__ void gemm160x16_mainloop(const u16* __restrict__ A, int lda, const u16* __restrict__ Bt, int ldb, int K, char* lds,
                                                    f32x4 (&acc)[10][2], const int tid) {
  const int wid = tid >> 6, lane = tid & 63, l16 = lane & 15, q4 = lane >> 4;
  const int srcch = (tid & 7) ^ ((tid >> 4) & 7);
  const u16* ag = A + (long)(tid >> 3) * lda + srcch * 8;
  const u16* bg = Bt + (long)(tid >> 3) * ldb + srcch * 8;
  const int swz = (l16 >> 1) & 7;
  const int aoff = l16 * 128, boff = 20480 + (wid * 32 + l16) * 128;
  const bool a3 = tid < 256;
#define ISSUE(kt, st) do { \
    _Pragma("unroll") for (int i = 0; i < 2; ++i) \
      __builtin_amdgcn_global_load_lds((const unsigned*)(ag + (long)(64 * i) * lda + (kt) * 64), (unsigned*)(lds + (st) * G160_STAGE + tid * 16 + i * 8192), 16, 0, 0); \
    if (a3) __builtin_amdgcn_global_load_lds((const unsigned*)(ag + (long)128 * lda + (kt) * 64), (unsigned*)(lds + (st) * G160_STAGE + tid * 16 + 16384), 16, 0, 0); \
    _Pragma("unroll") for (int i = 0; i < 4; ++i) \
      __builtin_amdgcn_global_load_lds((const unsigned*)(bg + (long)(64 * i) * ldb + (kt) * 64), (unsigned*)(lds + (st) * G160_STAGE + 20480 + tid * 16 + i * 8192), 16, 0, 0); } while (0)
#pragma unroll
  for (int a = 0; a < 10; ++a)
#pragma unroll
    for (int b = 0; b < 2; ++b) acc[a][b] = (f32x4){0.f, 0.f, 0.f, 0.f};
  const int nt = K >> 6;
  ISSUE(0, 0);
  for (int kt = 0; kt < nt; ++kt) {
    const int st = kt & 1;
    asm volatile("s_waitcnt vmcnt(0)" ::: "memory");
    __syncthreads();
    if (kt + 1 < nt) ISSUE(kt + 1, st ^ 1);
    const char* As = lds + st * G160_STAGE + aoff; const char* Bs = lds + st * G160_STAGE + boff;
    bf16x8 a0[10], b0[2], a1[10], b1[2];
#define FRAGS(ks, AF, BF) do { const int co = (((ks) * 4 + q4) ^ swz) << 4; \
      _Pragma("unroll") for (int mb = 0; mb < 10; ++mb) AF[mb] = *(const bf16x8*)(As + mb * 2048 + co); \
      _Pragma("unroll") for (int nb = 0; nb < 2; ++nb) BF[nb] = *(const bf16x8*)(Bs + nb * 2048 + co); } while (0)
#define MMAS(AF, BF) do { _Pragma("unroll") for (int mb = 0; mb < 10; ++mb) _Pragma("unroll") for (int nb = 0; nb < 2; ++nb) \
      acc[mb][nb] = __builtin_amdgcn_mfma_f32_16x16x32_bf16(BF[nb], AF[mb], acc[mb][nb], 0, 0, 0); } while (0)
#define SB() __builtin_amdgcn_sched_barrier(0)
    FRAGS(0, a0, b0); SB();
    FRAGS(1, a1, b1); SB();
    MMAS(a0, b0); SB();
    MMAS(a1, b1); SB();
#undef FRAGS
#undef MMAS
#undef SB
  }
  __syncthreads();
#undef ISSUE
}

__device__ __forceinline__ void gemm256x16_mainloop(const u16* __restrict__ A, int lda, const u16* __restrict__ Bt, int ldb, int K, char* lds,
                                                    f32x4 (&acc)[8][4], const int tid) {
  const int wid = tid >> 6, lane = tid & 63, l16 = lane & 15, q4 = lane >> 4, wm = wid >> 2, wn = wid & 3;
  const int srcch = (tid & 7) ^ ((tid >> 4) & 7);
  const u16* ag = A + (long)(tid >> 3) * lda + srcch * 8;
  const u16* bg = Bt + (long)(tid >> 3) * ldb + srcch * 8;
  const int swz = (l16 >> 1) & 7;
  const int aoff = (wm * 128 + l16) * 128, boff = (wn * 64 + l16) * 128;
#define ISSUE(kt, st) do { _Pragma("unroll") for (int i = 0; i < 4; ++i) { \
      __builtin_amdgcn_global_load_lds((const unsigned*)(ag + (long)(64 * i) * lda + (kt) * 64), (unsigned*)(lds + (st) * 65536 + tid * 16 + i * 8192), 16, 0, 0); \
      __builtin_amdgcn_global_load_lds((const unsigned*)(bg + (long)(64 * i) * ldb + (kt) * 64), (unsigned*)(lds + (st) * 65536 + 32768 + tid * 16 + i * 8192), 16, 0, 0); } } while (0)
#pragma unroll
  for (int a = 0; a < 8; ++a)
#pragma unroll
    for (int b = 0; b < 4; ++b) acc[a][b] = (f32x4){0.f, 0.f, 0.f, 0.f};
  const int nt = K >> 6;
  ISSUE(0, 0);
  for (int kt = 0; kt < nt; ++kt) {
    const int st = kt & 1;
    asm volatile("s_waitcnt vmcnt(0)" ::: "memory");
    __syncthreads();
    if (kt + 1 < nt) ISSUE(kt + 1, st ^ 1);
    const char* As = lds + st * 65536 + aoff; const char* Bs = lds + st * 65536 + 32768 + boff;
    bf16x8 aA[4], aB[4], bA[4];
#define LDA(ks, h, AF) do { const int co = (((ks) * 4 + q4) ^ swz) << 4; \
      _Pragma("unroll") for (int mb = 0; mb < 4; ++mb) AF[mb] = *(const bf16x8*)(As + ((h) * 4 + mb) * 2048 + co); } while (0)
#define LDB(ks, BF) do { const int co = (((ks) * 4 + q4) ^ swz) << 4; \
      _Pragma("unroll") for (int nb = 0; nb < 4; ++nb) BF[nb] = *(const bf16x8*)(Bs + nb * 2048 + co); } while (0)
#define MMAS(h, AF, BF) do { _Pragma("unroll") for (int mb = 0; mb < 4; ++mb) _Pragma("unroll") for (int nb = 0; nb < 4; ++nb) \
      acc[(h) * 4 + mb][nb] = __builtin_amdgcn_mfma_f32_16x16x32_bf16(BF[nb], AF[mb], acc[(h) * 4 + mb][nb], 0, 0, 0); } while (0)
#define SB() __builtin_amdgcn_sched_barrier(0)
    LDB(0, bA); LDA(0, 0, aA); SB();
    LDA(0, 1, aB); SB();
    MMAS(0, aA, bA); SB();
    LDA(1, 0, aA); SB();
    MMAS(1, aB, bA); SB();
    LDB(1, bA); LDA(1, 1, aB); SB();
    MMAS(0, aA, bA); SB();
    MMAS(1, aB, bA); SB();
#undef LDA
#undef LDB
#undef MMAS
#undef SB
  }
  __syncthreads();
#undef ISSUE
}

__device__ __forceinline__ int xcd_tile_index(int it) {
  return (gridDim.x == 256) ? ((it * 8 + (int)(blockIdx.x & 7)) * 32 + (int)(blockIdx.x >> 3)) : (int)(blockIdx.x + it * gridDim.x);
}
#define EPI_OFF(var, expr) long var = (long)(expr); asm volatile("" : "+v"(var) :: "memory")
#define CROW0(r) (((r) & 3) + 8 * ((r) >> 2))
#define WAVE_COORDS const int tid = opaque_tid(), wid = tid >> 6, lane = tid & 63, r32 = lane & 31, hi = lane >> 5, wm = wid >> 1, wn = wid & 1; (void)tid; (void)wm; (void)wn; (void)r32; (void)hi

__device__ __forceinline__ void phase_gemm_in(const Params& p_unused_, int l, char* lds) {
  PHASE_PARAMS;
  char* wsb = p.ws; asm volatile("" : "+s"(wsb));
  const int tid = opaque_tid(), wid = tid >> 6, lane = tid & 63, l16 = lane & 15, q4 = lane >> 4;
  const u16* h = (const u16*)(wsb + OFF_C);
  const u16* wt = (const u16*)(wsb + OFF_W + (size_t)l * WL_SIZE + WL_IN);
  u16* proj = (u16*)(wsb + A_PROJ);
  for (int it = 0;; ++it) {
    const int t = xcd_tile_index(it);
    if (t >= 256 * 5) break;
    const int mt = (t / 40) * 8 + (t & 7), nt = (t >> 3) % 5;
    f32x4 acc[10][2];
    gemm160x16_mainloop(h + (size_t)mt * 160 * 1024, 1024, wt + (size_t)nt * 256 * 1024, 1024, 1024, lds, acc, tid);
    const int col = nt * 256 + wid * 32 + q4 * 4;
#pragma unroll
    for (int mb = 0; mb < 10; ++mb) {
      EPI_OFF(eo, (long)(mt * 160 + mb * 16 + l16) * IN_COLS + col);
#pragma unroll
      for (int nb = 0; nb < 2; ++nb)
        if (col + 16 * nb < IN_COLS) {
          u32x2 w = {cvtpk(acc[mb][nb][0], acc[mb][nb][1]), cvtpk(acc[mb][nb][2], acc[mb][nb][3])};
          *(u32x2*)(proj + eo + 16 * nb) = w;
        }
    }
  }
}

__device__ __forceinline__ void phase_gemm_mix(const Params& p_unused_, int l, char* lds) {
  PHASE_PARAMS;
  char* wsb = p.ws; asm volatile("" : "+s"(wsb));
  WAVE_COORDS;
  char* wl = wsb + OFF_W + (size_t)l * WL_SIZE;
  const u16* proj = (const u16*)(wsb + A_PROJ);
  u16* mix = (u16*)(wsb + OFF_C);
  const float2* tab = (const float2*)(wsb + OFF_TAB);
  for (int it = 0;; ++it) {
    const int t = xcd_tile_index(it);
    if (t >= 3008) break;
    f32x16 acc[2][2];
    if (t < 960) {
      const int mt = t / 6, nt = t % 6;
      gemm_mainloop((const u16*)(wsb + A_QAN) + (size_t)mt * 256 * 256, 256, (const u16*)(wl + WL_QB) + (size_t)nt * 128 * 256, 256, 256, lds, acc, tid);
      u16* q = (u16*)(wsb + B_Q);
      const bool lat = mt >= 32;
#pragma unroll
      for (int mb = 0; mb < 2; ++mb)
#pragma unroll
        for (int nb = 0; nb < 2; ++nb) {
          const int n = nt * 128 + wn * 64 + nb * 32 + r32;
          const bool ropeblk = ((n >> 5) % 3) == 2;
          int m0q = mt * 256 + wm * 64 + mb * 32 + 4 * hi; asm volatile("" : "+v"(m0q) :: "memory");
          const long eo = (long)m0q * 768 + n;
#pragma unroll
          for (int r = 0; r < 16; ++r) {
            const int m = m0q + CROW0(r);
            float v = acc[mb][nb][r];
            if (lat && ropeblk) {
              const float pv = __shfl_xor(v, 8);
              const int s = (m - M_CTX) & 4095;
              const int axis = r32 >> 4, half = (r32 >> 3) & 1, f = r32 & 7;
              const int pos = axis ? (s & 63) : (s >> 6);
              const float2 cs = tab[pos * 8 + f];
              v = half ? (v * cs.x + pv * cs.y) : (v * cs.x - pv * cs.y);
            }
            q[eo + CROW0(r) * 768] = f2bf(v);
          }
        }
    } else if (t < 2368) {
      const int tt = t - 960, mt = tt >> 3, nt = tt & 7;
      gemm_mainloop((const u16*)(wsb + A_CKV) + (size_t)mt * 256 * 128, 128, (const u16*)(wl + WL_KVB) + (size_t)nt * 128 * 128, 128, 128, lds, acc, tid);
      u16* kv = (u16*)(wsb + B_KV);
#pragma unroll
      for (int mb = 0; mb < 2; ++mb)
#pragma unroll
        for (int nb = 0; nb < 2; ++nb) {
          const int n = nt * 128 + wn * 64 + nb * 32 + r32;
          { EPI_OFF(eo, (long)(mt * 256 + wm * 64 + mb * 32 + 4 * hi) * 1024 + n);
            _Pragma("unroll") for (int r = 0; r < 16; ++r) kv[eo + CROW0(r) * 1024] = f2bf(acc[mb][nb][r]); }
        }
    } else if (t < 2688) {
      const int tt = t - 2368, mt = tt >> 1, nt = tt & 1;
      gemm_mainloop((const u16*)(wsb + A_DPOOL) + (size_t)mt * 256 * 256, 256, (const u16*)(wl + WL_POOL) + (size_t)nt * 128 * 256, 256, 256, lds, acc, tid);
#pragma unroll
      for (int mb = 0; mb < 2; ++mb)
#pragma unroll
        for (int nb = 0; nb < 2; ++nb) {
          const int n = nt * 128 + wn * 64 + nb * 32 + r32;
          const float ps = p.pool_scale[l * 256 + n];
          { EPI_OFF(eo, (long)(mt * 256 + wm * 64 + mb * 32 + 4 * hi) * 1024 + 512 + n);
            _Pragma("unroll") for (int r = 0; r < 16; ++r) mix[eo + CROW0(r) * 1024] = f2bf(acc[mb][nb][r] * ps); }
        }
    } else {
      const int tt = t - 2688, h = tt / 80, mt = tt % 80;
      gemm_mainloop((const u16*)(wsb + A_VT) + ((size_t)h * 20480 + (size_t)mt * 256) * 128, 128, (const u16*)(wl + WL_SGU) + (size_t)h * 128 * 128, 128, 128, lds, acc, tid);
      const int chunk = mt * 4 + wm;
#pragma unroll
      for (int nb = 0; nb < 2; ++nb) {
        const int qq = wn * 64 + nb * 32 + r32;
        const float bias = p.b_sgu[((size_t)l * 4 + h) * 128 + qq];
        const size_t tok = (size_t)chunk * 128 + qq;
#pragma unroll
        for (int mb = 0; mb < 2; ++mb)
#pragma unroll
          for (int j = 0; j < 4; ++j) {
            const int d0 = mb * 32 + 8 * j + 4 * hi;
            const u32x2 uw = *(const u32x2*)(proj + tok * IN_COLS + 672 + h * 64 + d0);
            const float o0 = (acc[mb][nb][4 * j + 0] + bias) * bflo(uw[0]), o1 = (acc[mb][nb][4 * j + 1] + bias) * bfhi(uw[0]);
            const float o2 = (acc[mb][nb][4 * j + 2] + bias) * bflo(uw[1]), o3 = (acc[mb][nb][4 * j + 3] + bias) * bfhi(uw[1]);
            u32x2 w = {cvtpk(o0, o1), cvtpk(o2, o3)};
            *(u32x2*)(mix + tok * 1024 + 768 + h * 64 + d0) = w;
          }
      }
    }
  }
}

__device__ __forceinline__ void phase_gemm_f32out(const Params& p_unused_, size_t a_off, int K, size_t w_off, char* lds) {
  PHASE_PARAMS;
  char* wsb = p.ws; asm volatile("" : "+s"(wsb));
  const int tid = opaque_tid(), wid = tid >> 6, lane = tid & 63, l16 = lane & 15, q4 = lane >> 4;
  u16* obuf = (u16*)(wsb + OFF_B);
  const u16* A = (const u16*)(wsb + a_off); const u16* wt = (const u16*)(wsb + w_off);
  for (int it = 0;; ++it) {
    const int t = xcd_tile_index(it);
    if (t >= 256 * 4) break;
    const int mt = (t >> 5) * 8 + (t & 7), nt = (t >> 3) & 3;
    f32x4 acc[10][2];
    gemm160x16_mainloop(A + (size_t)mt * 160 * K, K, wt + (size_t)nt * 256 * K, K, K, lds, acc, tid);
#pragma unroll
    for (int mb = 0; mb < 10; ++mb) {
      EPI_OFF(eo, (long)(mt * 160 + mb * 16 + l16) * 1024 + nt * 256 + wid * 32 + q4 * 4);
#pragma unroll
      for (int nb = 0; nb < 2; ++nb) {
        u32x2 w = {cvtpk(acc[mb][nb][0], acc[mb][nb][1]), cvtpk(acc[mb][nb][2], acc[mb][nb][3])};
        *(u32x2*)(obuf + eo + 16 * nb) = w;
      }
    }
  }
}

constexpr int ZP = 264;
__device__ __forceinline__ void unpack8(const u32x4 w, float* f) {
  f[0] = bflo(w[0]); f[1] = bfhi(w[0]); f[2] = bflo(w[1]); f[3] = bfhi(w[1]); f[4] = bflo(w[2]); f[5] = bfhi(w[2]); f[6] = bflo(w[3]); f[7] = bfhi(w[3]);
}
__device__ __forceinline__ void phase_gemm_up(const Params& p_unused_, int l, char* lds) {
  PHASE_PARAMS;
  char* wsb = p.ws; asm volatile("" : "+s"(wsb));
  const int tid = opaque_tid(), wid = tid >> 6, lane = tid & 63, r32 = lane & 31, hi = lane >> 5, wm = wid >> 2, wn = wid & 3;
  const u16* h = (const u16*)(wsb + OFF_C);
  const u16* wt = (const u16*)(wsb + OFF_W + (size_t)l * WL_SIZE + WL_UP);
  u16* act_ = (u16*)(wsb + OFF_A);
  u16* halo_ = (u16*)(wsb + OFF_B);
  u16* zs = (u16*)lds;
  const float* cw_ = p.conv_w + (size_t)l * 3 * 5632;
  const float* cb_ = p.conv_b + (size_t)l * 5632;
  for (int it = 0;; ++it) {
    const int t = xcd_tile_index(it);
    if (t >= 160 * 22) break;
    const int mt = (t / 176) * 8 + (t & 7), nt = (t >> 3) % 22;
    f32x4 acc[8][4];
    gemm256x16_mainloop(h + (size_t)mt * 256 * 1024, 1024, wt + (size_t)nt * 256 * 1024, 1024, 1024, lds, acc, tid);
    {
      const int l16 = lane & 15, q4 = lane >> 4;
#pragma unroll
      for (int mb = 0; mb < 8; ++mb) {
        EPI_OFF(zo, (wm * 128 + mb * 16 + l16) * ZP + wn * 32 + q4 * 4);
#pragma unroll
        for (int nb = 0; nb < 4; ++nb) {
          u32x2 w = {cvtpk(acc[mb][nb][0], acc[mb][nb][1]), cvtpk(acc[mb][nb][2], acc[mb][nb][3])};
          *(u32x2*)(zs + zo + (nb >> 1) * 128 + (nb & 1) * 16) = w;
        }
      }
    }
    const int fch = tid & 15, rg = tid >> 4;
    int fg = nt * 128 + fch * 8;
    asm volatile("" : "+v"(fg) :: "memory");
    const float* cw = cw_; const float* cb = cb_; u16* act = act_; u16* halo = halo_;
    asm volatile("" : "+v"(cw), "+v"(cb), "+v"(act), "+v"(halo));
    const bool lat = mt >= 32;
    const bool top_zero = !lat || (((mt - 32) & 15) == 0), bot_zero = !lat || (((mt - 32) & 15) == 15);
    float cwg[3][8], cwv[3][8], cbg[8], cbv[8];
#pragma unroll
    for (int tp = 0; tp < 3; ++tp) {
      const float4 g0 = *(const float4*)(cw + tp * 5632 + fg), g1 = *(const float4*)(cw + tp * 5632 + fg + 4);
      const float4 v0 = *(const float4*)(cw + tp * 5632 + DFF + fg), v1 = *(const float4*)(cw + tp * 5632 + DFF + fg + 4);
      cwg[tp][0] = g0.x; cwg[tp][1] = g0.y; cwg[tp][2] = g0.z; cwg[tp][3] = g0.w; cwg[tp][4] = g1.x; cwg[tp][5] = g1.y; cwg[tp][6] = g1.z; cwg[tp][7] = g1.w;
      cwv[tp][0] = v0.x; cwv[tp][1] = v0.y; cwv[tp][2] = v0.z; cwv[tp][3] = v0.w; cwv[tp][4] = v1.x; cwv[tp][5] = v1.y; cwv[tp][6] = v1.z; cwv[tp][7] = v1.w;
    }
    {
      const float4 g0 = *(const float4*)(cb + fg), g1 = *(const float4*)(cb + fg + 4), v0 = *(const float4*)(cb + DFF + fg), v1 = *(const float4*)(cb + DFF + fg + 4);
      cbg[0] = g0.x; cbg[1] = g0.y; cbg[2] = g0.z; cbg[3] = g0.w; cbg[4] = g1.x; cbg[5] = g1.y; cbg[6] = g1.z; cbg[7] = g1.w;
      cbv[0] = v0.x; cbv[1] = v0.y; cbv[2] = v0.z; cbv[3] = v0.w; cbv[4] = v1.x; cbv[5] = v1.y; cbv[6] = v1.z; cbv[7] = v1.w;
    }
    __syncthreads();
    const int r0 = rg * 8;
    const u16* zg = zs + fch * 8;
    float pg[8], pv[8], cg[8], cv[8], ng[8], nv[8];
    if (r0 > 0) { unpack8(*(const u32x4*)(zg + (r0 - 1) * ZP), pg); unpack8(*(const u32x4*)(zg + (r0 - 1) * ZP + 128), pv); }
    else {
#pragma unroll
      for (int e = 0; e < 8; ++e) { pg[e] = 0.f; pv[e] = 0.f; }
    }
    unpack8(*(const u32x4*)(zg + r0 * ZP), cg); unpack8(*(const u32x4*)(zg + r0 * ZP + 128), cv);
#pragma unroll
    for (int j = 0; j < 8; ++j) {
      const int row = r0 + j;
      if (row < 255) { unpack8(*(const u32x4*)(zg + (row + 1) * ZP), ng); unpack8(*(const u32x4*)(zg + (row + 1) * ZP + 128), nv); }
      else {
#pragma unroll
        for (int e = 0; e < 8; ++e) { ng[e] = 0.f; nv[e] = 0.f; }
      }
      if (lat && (row < 2 || row >= 254)) {
        const int hr = row < 2 ? row : row - 252;
        *(u32x4*)(halo + ((size_t)mt * 4 + hr) * 5632 + fg) = *(const u32x4*)(zg + row * ZP);
        *(u32x4*)(halo + ((size_t)mt * 4 + hr) * 5632 + DFF + fg) = *(const u32x4*)(zg + row * ZP + 128);
      }
      const bool skip = (row == 0 && !top_zero) || (row == 255 && !bot_zero);
      if (!skip) {
        float o[8];
#pragma unroll
        for (int e = 0; e < 8; ++e) {
          const float gg = cwg[0][e] * pg[e] + cwg[1][e] * cg[e] + cwg[2][e] * ng[e] + cbg[e];
          const float vv = cwv[0][e] * pv[e] + cwv[1][e] * cv[e] + cwv[2][e] * nv[e] + cbv[e];
          o[e] = silu_f(gg) * vv;
        }
        u32x4 w = {cvtpk(o[0], o[1]), cvtpk(o[2], o[3]), cvtpk(o[4], o[5]), cvtpk(o[6], o[7])};
        *(u32x4*)(act + (size_t)(mt * 256 + row) * DFF + fg) = w;
      }
#pragma unroll
      for (int e = 0; e < 8; ++e) { pg[e] = cg[e]; pv[e] = cv[e]; cg[e] = ng[e]; cv[e] = nv[e]; }
    }
    __syncthreads();
  }
}

__device__ __forceinline__ void phase_fixup(const Params& p_unused_, int l) {
  PHASE_PARAMS;
  char* wsb = p.ws; asm volatile("" : "+s"(wsb));
  const int tid = opaque_tid();
  u16* act = (u16*)(wsb + OFF_A);
  const u16* halo = (const u16*)(wsb + OFF_B);
  const float* cw = p.conv_w + (size_t)l * 3 * 5632;
  const float* cb = p.conv_b + (size_t)l * 5632;
  for (int u = blockIdx.x; u < 256; u += gridDim.x) {
    const int mt = 32 + (u >> 1), e = u & 1;
    const int row = e ? 255 : 0, m = mt * 256 + row, s = (m - M_CTX) & 4095;
    if ((e == 0 && s == 0) || (e == 1 && s == S_LAT - 1)) continue;
    const u16* up = e == 0 ? halo + ((size_t)(mt - 1) * 4 + 3) * 5632 : halo + ((size_t)mt * 4 + 2) * 5632;
    const u16* own = e == 0 ? halo + ((size_t)mt * 4 + 0) * 5632 : halo + ((size_t)mt * 4 + 3) * 5632;
    const u16* dn = e == 0 ? halo + ((size_t)mt * 4 + 1) * 5632 : halo + ((size_t)(mt + 1) * 4 + 0) * 5632;
    if (tid < DFF / 8) {
      const int f = tid * 8;
      float ug[8], og[8], dg[8], uv[8], ov[8], dv[8], o[8];
      unpack8(*(const u32x4*)(up + f), ug); unpack8(*(const u32x4*)(own + f), og); unpack8(*(const u32x4*)(dn + f), dg);
      unpack8(*(const u32x4*)(up + DFF + f), uv); unpack8(*(const u32x4*)(own + DFF + f), ov); unpack8(*(const u32x4*)(dn + DFF + f), dv);
#pragma unroll
      for (int e8 = 0; e8 < 8; ++e8) {
        const float gg = cw[f + e8] * ug[e8] + cw[5632 + f + e8] * og[e8] + cw[2 * 5632 + f + e8] * dg[e8] + cb[f + e8];
        const float vv = cw[DFF + f + e8] * uv[e8] + cw[5632 + DFF + f + e8] * ov[e8] + cw[2 * 5632 + DFF + f + e8] * dv[e8] + cb[DFF + f + e8];
        o[e8] = silu_f(gg) * vv;
      }
      u32x4 w = {cvtpk(o[0], o[1]), cvtpk(o[2], o[3]), cvtpk(o[4], o[5]), cvtpk(o[6], o[7])};
      *(u32x4*)(act + (size_t)m * DFF + f) = w;
    }
  }
}

constexpr int VSP = 264;
__device__ __forceinline__ void phase_mid(const Params& p_unused_, int l, char* lds) {
  PHASE_PARAMS;
  char* wsb = p.ws; asm volatile("" : "+s"(wsb));
  const int tid = opaque_tid(), wid = tid >> 6, lane = tid & 63;
  const u16* proj = (const u16*)(wsb + A_PROJ);
  u16* qan = (u16*)(wsb + A_QAN);
  u16* ckva = (u16*)(wsb + A_CKV);
  u16* dpool = (u16*)(wsb + A_DPOOL);
  u16* vT = (u16*)(wsb + A_VT);
  u16* krope = (u16*)(wsb + B_KR);
  const float2* tab = (const float2*)(wsb + OFF_TAB);
  u16* vs = (u16*)lds;
  const float4 c_gq = *(const float4*)(p.g_q_a + l * 256 + lane * 4), c_gs = *(const float4*)(p.g_sgu + l * 256 + lane * 4);
  const float2 c_gk = *(const float2*)(p.g_kv_a + l * 128 + lane * 2);
  for (int u = blockIdx.x; u < 704; u += gridDim.x) {
    if (u < 640) {
      const int chunk = u >> 1, half = u & 1;
      float a0 = 0.f, a1 = 0.f, a2 = 0.f, a3 = 0.f; int pw_lo = 0, pw_hi = 0;
      for (int tl = wid * 8; tl < wid * 8 + 8; ++tl) {
        const int m = u * 64 + tl;
        const bool ctx = m < M_CTX;
        int b, s, S, kvrow;
        if (ctx) { b = m >> 8; s = m & 255; S = S_CTX; kvrow = m; }
        else { const int mm = m - M_CTX; b = mm >> 12; s = mm & 4095; S = S_LAT; kvrow = M_CTX + b * T_LAT + PAST + s; }
        const u16* pr = proj + (size_t)m * IN_COLS;
        {
          const u32x2 w = *(const u32x2*)(pr + lane * 4);
          const float x0 = bflo(w[0]), x1 = bfhi(w[0]), x2 = bflo(w[1]), x3 = bfhi(w[1]);
          const float ss = wave_sum(x0 * x0 + x1 * x1 + x2 * x2 + x3 * x3);
          const float rstd = rsqrtf(ss * (1.f / 256.f) + EPS);
          const float4 g = c_gq;
          u32x2 o = {cvtpk(x0 * rstd * g.x, x1 * rstd * g.y), cvtpk(x2 * rstd * g.z, x3 * rstd * g.w)};
          *(u32x2*)(qan + (size_t)m * 256 + lane * 4) = o;
        }
        {
          const unsigned w = *(const unsigned*)(pr + 256 + lane * 2);
          const float x0 = bflo(w), x1 = bfhi(w);
          const float ss = wave_sum(x0 * x0 + x1 * x1);
          const float rstd = rsqrtf(ss * (1.f / 128.f) + EPS);
          const float2 g = c_gk;
          const float y0 = x0 * rstd * g.x, y1 = x1 * rstd * g.y;
          *(unsigned*)(ckva + (size_t)kvrow * 128 + lane * 2) = cvtpk(y0, y1);
          if (ctx) *(float2*)(p.out + OUT_CKV + (((size_t)b * 2 + l) * 256 + s) * 128 + lane * 2) = make_float2(y0, y1);
        }
        {
          const float x = bf2f(pr[384 + (lane & 31)]);
          const float pv = __shfl_xor(x, 8);
          float y = x;
          if (!ctx) {
            const int rr = lane & 31, axis = rr >> 4, half = (rr >> 3) & 1, f = rr & 7;
            const int pos = axis ? (s & 63) : (s >> 6);
            const float2 cs = tab[pos * 8 + f];
            y = half ? (x * cs.x + pv * cs.y) : (x * cs.x - pv * cs.y);
          }
          if (lane < 32) {
            krope[(size_t)kvrow * 32 + lane] = f2bf(y);
            if (ctx) p.out[OUT_KR + (((size_t)b * 2 + l) * 256 + s) * 32 + lane] = x;
          }
        }
        {
          const int g = lane >> 4, half = 1 << g;
          const int lo = max(s - half, 0), hi_ = min(s + half, S);
          const u16* pb = proj + (size_t)(m - s) * IN_COLS + 416 + lane * 4;
          for (int t = max(pw_hi, lo); t < hi_; ++t) {
            const u32x2 w = *(const u32x2*)(pb + (size_t)t * IN_COLS);
            a0 += bflo(w[0]); a1 += bfhi(w[0]); a2 += bflo(w[1]); a3 += bfhi(w[1]);
          }
          for (int t = pw_lo; t < min(lo, pw_hi); ++t) {
            const u32x2 w = *(const u32x2*)(pb + (size_t)t * IN_COLS);
            a0 -= bflo(w[0]); a1 -= bfhi(w[0]); a2 -= bflo(w[1]); a3 -= bfhi(w[1]);
          }
          pw_lo = lo; pw_hi = hi_;
          const u32x2 w = *(const u32x2*)(pb + (size_t)s * IN_COLS);
          const float inv = __builtin_amdgcn_rcpf((float)(hi_ - lo));
          u32x2 o = {cvtpk(a0 * inv - bflo(w[0]), a1 * inv - bfhi(w[0])), cvtpk(a2 * inv - bflo(w[1]), a3 * inv - bfhi(w[1]))};
          *(u32x2*)(dpool + (size_t)m * 256 + lane * 4) = o;
        }
        {
          const u32x2 w = *(const u32x2*)(pr + 928 + lane * 4);
          const float x0 = bflo(w[0]), x1 = bfhi(w[0]), x2 = bflo(w[1]), x3 = bfhi(w[1]);
          const float ss = wave_sum(x0 * x0 + x1 * x1 + x2 * x2 + x3 * x3);
          const float rstd = rsqrtf(ss * (1.f / 256.f) + EPS);
          const float4 g = c_gs;
          u32x2 o = {cvtpk(x0 * rstd * g.x, x1 * rstd * g.y), cvtpk(x2 * rstd * g.z, x3 * rstd * g.w)};
          *(u32x2*)(vs + tl * VSP + lane * 4) = o;
        }
      }
      __syncthreads();
#pragma unroll 1
      for (int i = 0; i < 4; ++i) {
        const int hd = (tid >> 3) + 64 * i, ps = tid & 7, h = hd >> 6, d = hd & 63;
        u16 e[8];
#pragma unroll
        for (int j = 0; j < 8; ++j) e[j] = vs[(ps * 8 + j) * VSP + hd];
        u32x4 w = {(unsigned)e[0] | ((unsigned)e[1] << 16), (unsigned)e[2] | ((unsigned)e[3] << 16), (unsigned)e[4] | ((unsigned)e[5] << 16), (unsigned)e[6] | ((unsigned)e[7] << 16)};
        *(u32x4*)(vT + (((size_t)h * 320 + chunk) * 64 + d) * 128 + half * 64 + ps * 8) = w;
      }
      __syncthreads();
    } else {
      const int uu = u - 640, b = uu >> 3, t0 = (uu & 7) * 64;
      for (int tl = wid; tl < 64; tl += 8) {
        const int t = t0 + tl; const size_t kvrow = (size_t)M_CTX + (size_t)b * T_LAT + t;
        const float2 v = *(const float2*)(p.cache_ckv + (((size_t)b * 2 + l) * PAST + t) * 128 + lane * 2);
        *(unsigned*)(ckva + kvrow * 128 + lane * 2) = cvtpk(v.x, v.y);
        if (lane < 32) krope[kvrow * 32 + lane] = f2bf(p.cache_krope[(((size_t)b * 2 + l) * PAST + t) * 32 + lane]);
      }
    }
  }
}

constexpr int SHM_V = 64 * 128 * 2, SHM_K = 64 * 128 * 2;
constexpr float ATT_SCALE = 0.10206207261596575f;
constexpr float ATT_THR = 8.f;
#define KSWZ(row, colB) ((row) * 256 + ((colB) ^ (((row) & 15) << 4)))
#define SBAR() __builtin_amdgcn_sched_barrier(0)

__device__ __forceinline__ void partialSM(f32x16& p0, f32x16& p1, float& m_reg, float& mn, float& alpha) {
  constexpr float C = ATT_SCALE * 1.4426950408889634f;
  float pmax = p0[0];
#pragma unroll
  for (int r = 1; r < 16; ++r) pmax = fmaxf(pmax, p0[r]);
#pragma unroll
  for (int r = 0; r < 16; ++r) pmax = fmaxf(pmax, p1[r]);
  { auto rr = __builtin_amdgcn_permlane32_swap(__float_as_uint(pmax), __float_as_uint(pmax), false, false);
    pmax = fmaxf(__uint_as_float(rr[0]), __uint_as_float(rr[1])); }
  if (__builtin_expect(__all(pmax - m_reg <= ATT_THR / ATT_SCALE), 1)) { mn = m_reg; alpha = 1.f; }
  else { mn = fmaxf(m_reg, pmax); alpha = __builtin_amdgcn_exp2f((m_reg - mn) * C); m_reg = mn; }
  const float mnC = -mn * C;
#pragma unroll
  for (int r = 0; r < 16; ++r) p0[r] = fmaf(p0[r], C, mnC);
#pragma unroll
  for (int r = 0; r < 16; ++r) p1[r] = fmaf(p1[r], C, mnC);
#pragma unroll
  for (int r = 0; r < 16; ++r) p0[r] = __builtin_amdgcn_exp2f(p0[r]);
}
__device__ __forceinline__ void finishSM(f32x16& p0, f32x16& p1, float alpha, float& l_reg, bf16x8& pa0, bf16x8& pa1, bf16x8& pa2, bf16x8& pa3) {
#pragma unroll
  for (int r = 0; r < 16; ++r) p1[r] = __builtin_amdgcn_exp2f(p1[r]);
  float ps = 0;
#pragma unroll
  for (int r = 0; r < 16; ++r) ps += p0[r];
#pragma unroll
  for (int r = 0; r < 16; ++r) ps += p1[r];
  { auto rr = __builtin_amdgcn_permlane32_swap(__float_as_uint(ps), __float_as_uint(ps), false, false);
    ps = __uint_as_float(rr[0]) + __uint_as_float(rr[1]); }
  l_reg = l_reg * alpha + ps;
#define PK4(P, BASE, OUT) do { unsigned a0 = cvtpk(P[BASE + 0], P[BASE + 1]), a1 = cvtpk(P[BASE + 2], P[BASE + 3]);   \
    unsigned b0 = cvtpk(P[BASE + 4], P[BASE + 5]), b1 = cvtpk(P[BASE + 6], P[BASE + 7]);                              \
    auto r0 = __builtin_amdgcn_permlane32_swap(a0, b0, false, false); auto r1 = __builtin_amdgcn_permlane32_swap(a1, b1, false, false); \
    u32x4 w = {r0[0], r1[0], r0[1], r1[1]}; OUT = *reinterpret_cast<bf16x8*>(&w); } while (0)
  PK4(p0, 0, pa0); PK4(p0, 8, pa1); PK4(p1, 0, pa2); PK4(p1, 8, pa3);
#undef PK4
}
__device__ __forceinline__ void qkt(f32x16& p0, f32x16& p1, const char* Ks, const bf16x8* qr, int r32, int hi) {
#pragma unroll
  for (int r = 0; r < 16; ++r) { p0[r] = 0.f; p1[r] = 0.f; }
#pragma unroll
  for (int d0 = 0; d0 < 6; ++d0) { const int cb = (d0 * 16 + hi * 8) * 2;
    const bf16x8 b0 = *reinterpret_cast<const bf16x8*>(Ks + KSWZ(r32, cb));
    const bf16x8 b1 = *reinterpret_cast<const bf16x8*>(Ks + KSWZ(32 + r32, cb));
    p0 = __builtin_amdgcn_mfma_f32_32x32x16_bf16(b0, qr[d0], p0, 0, 0, 0);
    p1 = __builtin_amdgcn_mfma_f32_32x32x16_bf16(b1, qr[d0], p1, 0, 0, 0); }
}
__device__ __forceinline__ int v_st(int k, int c) { const int kk = (k & ~0xC) | ((k & 4) << 1) | ((k & 8) >> 1); return ((kk >> 3) * 4 + (c >> 5)) * 512 + ((kk & 7) * 32 + (c & 31)) * 2; }
__device__ __forceinline__ int v_rd_base(int lane) { return ((lane & 3) << 3) | (((lane >> 2) & 3) << 6) | (((lane >> 4) & 1) << 5) | (((lane >> 5) & 1) << 8); }
constexpr int v_rd_off(int d0, int ks, int half) { return d0 * 512 + ks * 4096 + half * 2048; }
template <int OFF> __device__ __forceinline__ s16x4 tr_read(int vb) {
  s16x4 r; asm volatile("ds_read_b64_tr_b16 %0, %1 offset:%2" : "=&v"(r) : "v"(vb), "i"(OFF) : "memory"); return r;
}
template <int D0> __device__ __forceinline__ void pv_one(f32x16& od, int vb, bf16x8 pa0, bf16x8 pa1, bf16x8 pa2, bf16x8 pa3) {
  const s16x4 l0 = tr_read<v_rd_off(D0, 0, 0)>(vb), h0 = tr_read<v_rd_off(D0, 0, 1)>(vb), l1 = tr_read<v_rd_off(D0, 1, 0)>(vb), h1 = tr_read<v_rd_off(D0, 1, 1)>(vb);
  const s16x4 l2 = tr_read<v_rd_off(D0, 2, 0)>(vb), h2 = tr_read<v_rd_off(D0, 2, 1)>(vb), l3 = tr_read<v_rd_off(D0, 3, 0)>(vb), h3 = tr_read<v_rd_off(D0, 3, 1)>(vb);
  asm volatile("s_waitcnt lgkmcnt(0)" ::: "memory"); SBAR();
#define PK(L, H) (bf16x8){L[0], L[1], L[2], L[3], H[0], H[1], H[2], H[3]}
  od = __builtin_amdgcn_mfma_f32_32x32x16_bf16(pa0, PK(l0, h0), od, 0, 0, 0);
  od = __builtin_amdgcn_mfma_f32_32x32x16_bf16(pa1, PK(l1, h1), od, 0, 0, 0);
  od = __builtin_amdgcn_mfma_f32_32x32x16_bf16(pa2, PK(l2, h2), od, 0, 0, 0);
  od = __builtin_amdgcn_mfma_f32_32x32x16_bf16(pa3, PK(l3, h3), od, 0, 0, 0);
#undef PK
}
__device__ __forceinline__ void pv_d0(f32x16* o, int vb, bf16x8 pa0, bf16x8 pa1, bf16x8 pa2, bf16x8 pa3) {
  pv_one<0>(o[0], vb, pa0, pa1, pa2, pa3); pv_one<1>(o[1], vb, pa0, pa1, pa2, pa3);
}

__device__ __forceinline__ void attn_body(const u16* __restrict__ Qb, const u16* __restrict__ Kh, const u16* __restrict__ KRh,
                                          const u16* __restrict__ Vh, u16* __restrict__ Ob, int seq, char* lds) {
  const int tid = opaque_tid(), wid = tid >> 6, lane = tid & 63, r32 = lane & 31, hi = lane >> 5;
  char* V_lds = lds; char* K_lds = lds + 2 * SHM_V;
  float* ws = (float*)(lds + 2 * SHM_V + 2 * SHM_K) + wid * 64; float* li_l = ws; float* al_l = ws + 32;
  float m_reg = -1e30f, l_reg = 0; f32x16 o[2]; bf16x8 qr[6];
#pragma unroll
  for (int r = 0; r < 16; ++r) { o[0][r] = 0.f; o[1][r] = 0.f; }
  const u16* Qw = Qb + (long)(wid * 32 + r32) * 768 + hi * 8;
#pragma unroll
  for (int d0 = 0; d0 < 6; ++d0) qr[d0] = *reinterpret_cast<const bf16x8*>(Qw + d0 * 16);
  const int sr = tid >> 4, c16 = tid & 15;
  const u16* kp; int kstr;
  if (c16 < 8) { kp = Kh + (long)sr * 1024 + c16 * 8; kstr = 1024; } else { kp = KRh + (long)sr * 32 + ((c16 - 8) & 3) * 8; kstr = 32; }
  const int kst0 = KSWZ(sr, c16 * 16), kst1 = KSWZ(32 + sr, c16 * 16);
  const int vkey = tid >> 3, vc = (tid & 7) * 8; const u16* vp = Vh + (long)vkey * 1024 + vc; const int vst = v_st(vkey, vc);
  const int vb0 = (int)(uintptr_t)V_lds + v_rd_base(lane);
  bf16x8 sv0, sk00, sk01, sv1, sk10, sk11;
#define SLOAD0(k0) do { sv0 = *(const bf16x8*)(vp + (long)(k0) * 1024); sk00 = *(const bf16x8*)(kp + (long)(k0) * kstr); sk01 = *(const bf16x8*)(kp + (long)((k0) + 32) * kstr); } while (0)
#define SLOAD1(k0) do { sv1 = *(const bf16x8*)(vp + (long)(k0) * 1024); sk10 = *(const bf16x8*)(kp + (long)(k0) * kstr); sk11 = *(const bf16x8*)(kp + (long)((k0) + 32) * kstr); } while (0)
#define SWRITE0(b) do { *(bf16x8*)(V_lds + (b) * SHM_V + vst) = sv0; *(bf16x8*)(K_lds + (b) * SHM_K + kst0) = sk00; *(bf16x8*)(K_lds + (b) * SHM_K + kst1) = sk01; } while (0)
#define SWRITE1(b) do { *(bf16x8*)(V_lds + (b) * SHM_V + vst) = sv1; *(bf16x8*)(K_lds + (b) * SHM_K + kst0) = sk10; *(bf16x8*)(K_lds + (b) * SHM_K + kst1) = sk11; } while (0)
#define SWAIT() asm volatile("s_waitcnt vmcnt(3)" ::: "memory")
#define RESC(a) do { if (__any((a) < 1.f)) { if (hi == 0) al_l[r32] = (a); asm volatile("s_waitcnt lgkmcnt(0)" ::: "memory"); \
    _Pragma("unroll") for (int d = 0; d < 2; ++d) _Pragma("unroll") for (int r = 0; r < 16; ++r) o[d][r] *= al_l[crow(r, hi)]; } } while (0)
  f32x16 pA0, pA1, pB0, pB1; float mnA, mnB, alA, alB; bf16x8 pa0, pa1, pa2, pa3; const int NT = seq / 64;
  SLOAD0(0); asm volatile("s_waitcnt vmcnt(0)" ::: "memory"); SWRITE0(0); __syncthreads();
  qkt(pA0, pA1, K_lds, qr, r32, hi); partialSM(pA0, pA1, m_reg, mnA, alA);
  SLOAD1(64); if (2 < NT) SLOAD0(2 * 64);
  SWAIT(); SWRITE1(1); __syncthreads();
  for (int j = 1; j + 1 < NT; j += 2) {
    SBAR(); qkt(pB0, pB1, K_lds + SHM_K, qr, r32, hi);
    finishSM(pA0, pA1, alA, l_reg, pa0, pa1, pa2, pa3); SBAR();
    SLOAD1((j + 2) * 64); SBAR();
    pv_d0(o, vb0, pa0, pa1, pa2, pa3); partialSM(pB0, pB1, m_reg, mnB, alB);
    __syncthreads(); SWAIT(); SWRITE0(0);
    RESC(alB); __syncthreads();
    SBAR(); qkt(pA0, pA1, K_lds, qr, r32, hi);
    finishSM(pB0, pB1, alB, l_reg, pa0, pa1, pa2, pa3); SBAR();
    if (j + 3 < NT) SLOAD0((j + 3) * 64); SBAR();
    pv_d0(o, vb0 + SHM_V, pa0, pa1, pa2, pa3); partialSM(pA0, pA1, m_reg, mnA, alA);
    __syncthreads(); SWAIT(); SWRITE1(1);
    RESC(alA); __syncthreads();
  }
  SBAR(); qkt(pB0, pB1, K_lds + SHM_K, qr, r32, hi);
  finishSM(pA0, pA1, alA, l_reg, pa0, pa1, pa2, pa3); SBAR();
  pv_d0(o, vb0, pa0, pa1, pa2, pa3); partialSM(pB0, pB1, m_reg, mnB, alB);
  __syncthreads(); RESC(alB);
  finishSM(pB0, pB1, alB, l_reg, pa0, pa1, pa2, pa3); SBAR();
  pv_d0(o, vb0 + SHM_V, pa0, pa1, pa2, pa3);
  if (hi == 0) li_l[r32] = l_reg; asm volatile("s_waitcnt lgkmcnt(0)" ::: "memory");
  u16* Ow = Ob + (long)(wid * 32) * 1024;
#pragma unroll
  for (int r = 0; r < 16; ++r) { const int orow = crow(r, hi); const float rl = __builtin_amdgcn_rcpf(li_l[orow]);
#pragma unroll
    for (int d0 = 0; d0 < 2; ++d0) Ow[(long)orow * 1024 + d0 * 32 + r32] = f2bf(o[d0][r] * rl); }
#undef SLOAD0
#undef SLOAD1
#undef SWRITE0
#undef SWRITE1
#undef SWAIT
#undef RESC
}

__device__ __forceinline__ void phase_attn(const Params& p_unused_, char* lds) {
  PHASE_PARAMS;
  char* wsb = p.ws; asm volatile("" : "+s"(wsb));
  const u16* q = (const u16*)(wsb + B_Q);
  const u16* kv = (const u16*)(wsb + B_KV);
  const u16* kr = (const u16*)(wsb + B_KR);
  u16* mix = (u16*)(wsb + OFF_C);
  for (int u = blockIdx.x; u < 1280; u += gridDim.x) {
    size_t m0, kvrow0; int h, seq;
    if (u < 1024) {
      const int it = u >> 8, i = u & 255, xcd = i & 7, j = i >> 3;
      const int bh = it * 16 + xcd * 2 + (j >> 4), qb = j & 15, b = bh >> 3;
      h = bh & 7; m0 = (size_t)M_CTX + (size_t)b * S_LAT + qb * 256; kvrow0 = (size_t)M_CTX + (size_t)b * T_LAT; seq = T_LAT;
    } else {
      const int uu = u - 1024, b = uu >> 3; h = uu & 7; m0 = (size_t)b * 256; kvrow0 = m0; seq = S_CTX;
    }
    __syncthreads();
    attn_body(q + m0 * 768 + h * 96, kv + kvrow0 * 1024 + h * 128, kr + kvrow0 * 32, kv + kvrow0 * 1024 + h * 128 + 64, mix + m0 * 1024 + h * 64, seq, lds);
  }
}


#define XB_TMO      128
#define XB_XCNT(j)  (256  + 64 * (j))
#define XB_XSUB(j)  (1280 + 64 * (j))
#define XB_XGEN(j)  (2304 + 64 * (j))
#define XB_TOP      3328
#define XB_TOPGEN   3392
#define XCD_BAR_WORDS 3456
#define XB_SPIN_CAP (1u << 18)
#define LAS __attribute__((address_space(3)))
__device__ __forceinline__ unsigned xb_ld(unsigned* p)              { return __hip_atomic_load(p, __ATOMIC_RELAXED, __HIP_MEMORY_SCOPE_AGENT); }
__device__ __forceinline__ unsigned xb_add(unsigned* p, unsigned v) { return __hip_atomic_fetch_add(p, v, __ATOMIC_RELAXED, __HIP_MEMORY_SCOPE_AGENT); }
__device__ __forceinline__ unsigned xb_xcc_id() { return (unsigned)__builtin_amdgcn_s_getreg((3 << 11) | 20) & 0xFu; }
#define XB_SPIN(cond, bar) do { unsigned _sp = 0; while (cond) { __builtin_amdgcn_s_sleep(1); \
    if ((++_sp & 255u) == 0u) { if (xb_ld(&(bar)[XB_TMO])) break; if (_sp > XB_SPIN_CAP) { atomicAdd(&(bar)[XB_TMO], 1u); break; } } } } while (0)
struct XcdBarrier { unsigned* bar; unsigned x; volatile LAS unsigned* st; };
__device__ __forceinline__ XcdBarrier xcd_barrier_post(unsigned* bar, volatile LAS unsigned* st) {
  XcdBarrier b; b.bar = bar; b.x = (unsigned)__builtin_amdgcn_readfirstlane((int)xb_xcc_id()); b.st = st;
  if (threadIdx.x == 0) (void)xb_add(&bar[XB_XCNT(b.x)], 1u);
  return b;
}
__device__ __forceinline__ void xcd_barrier_complete(unsigned* bar, unsigned x, unsigned& nloc, unsigned& nx) {
  const unsigned G = gridDim.x * gridDim.y * gridDim.z;
  unsigned sum, cnt, mine, sp = 0u;
  for (;;) {
    sum = 0u; cnt = 0u; mine = 0u;
#pragma unroll
    for (unsigned j = 0; j < 16; ++j) { const unsigned c = xb_ld(&bar[XB_XCNT(j)]); sum += c; cnt += (c > 0u) ? 1u : 0u; mine = (j == x) ? c : mine; }
    if (sum == G) break;
    __builtin_amdgcn_s_sleep(1);
    if ((++sp & 255u) == 0u) { if (xb_ld(&bar[XB_TMO])) break; if (sp > XB_SPIN_CAP) { atomicAdd(&bar[XB_TMO], 1u); break; } }
  }
  nloc = mine > 0u ? mine : 1u; nx = cnt > 0u ? cnt : 1u;
}
__device__ __forceinline__ void xcd_barrier(const XcdBarrier& b) {
  asm volatile("s_waitcnt vmcnt(0)" ::: "memory");
  __syncthreads();
  if (threadIdx.x == 0) {
    unsigned* bar = b.bar; asm volatile("" : "+s"(bar));
    unsigned bx = b.x; asm volatile("" : "+s"(bx));
    __builtin_amdgcn_s_waitcnt(0);
    unsigned nloc = b.st[0], nx = b.st[1];
    if (nloc == 0u) { xcd_barrier_complete(bar, bx, nloc, nx); b.st[0] = nloc; b.st[1] = nx; }
    const unsigned old = xb_add(&bar[XB_XSUB(bx)], 1u);
    const unsigned gen = old / nloc;
    if (old + 1u == (gen + 1u) * nloc) {
      __builtin_amdgcn_fence(__ATOMIC_RELEASE, "agent");
      asm volatile("s_waitcnt vmcnt(0)" ::: "memory");
      const unsigned og = xb_add(&bar[XB_TOP], 1u);
      const unsigned tg = og / nx;
      if (og + 1u == (tg + 1u) * nx) xb_add(&bar[XB_TOPGEN], 1u);
      else XB_SPIN(xb_ld(&bar[XB_TOPGEN]) == tg, bar);
      __builtin_amdgcn_fence(__ATOMIC_ACQUIRE, "agent");
      xb_add(&bar[XB_XGEN(bx)], 1u);
      asm volatile("s_waitcnt vmcnt(0)" ::: "memory");
    } else {
      XB_SPIN(xb_ld(&bar[XB_XGEN(bx)]) == gen, bar);
      __builtin_amdgcn_fence(__ATOMIC_ACQUIRE, "agent");
      asm volatile("s_waitcnt vmcnt(0)" ::: "memory");
    }
  }
  __syncthreads();
}
#define GSYNC() xcd_barrier(xb)

#ifndef STOP_AT
#define STOP_AT 0
#endif
__device__ __forceinline__ void phase_dump(const Params& p, const u16* buf, size_t count, int isf32) {
  const size_t n = 44564480;
  for (size_t i = (size_t)blockIdx.x * NTHR + threadIdx.x; i < n; i += (size_t)gridDim.x * NTHR) {
    float v = 0.f;
    if (i < count) v = isf32 ? ((const float*)buf)[i] : bf2f(buf[i]);
    if (!(fabsf(v) < 1e30f)) v = 7777.f;
    p.out[i] = v;
  }
}
#define STOP(k, buf, count, isf32) do { if (STOP_AT == (k)) { GSYNC(); phase_dump(p, (const u16*)(buf), (count), (isf32)); return; } } while (0)
__global__ void __launch_bounds__(NTHR) fwd_megakernel(Params p) {
  extern __shared__ __attribute__((aligned(16))) char lds[];
  cg::grid_group grid = cg::this_grid();
  if (p.out == nullptr) grid.sync();
  volatile LAS unsigned* xst = (volatile LAS unsigned*)(lds + LDS_MAIN);
  if (threadIdx.x == 0) { xst[0] = 0u; xst[1] = 0u; }
  __syncthreads();
  XcdBarrier xb = xcd_barrier_post((unsigned*)(p.ws + OFF_BAR), xst);
  phase_prep(p, lds);
  STOP(1, p.ws + OFF_W, (OFF_TAB + 4096) / 2, 0);
  GSYNC();
  phase_rows(p, 0, 0);
  STOP(2, p.ws + OFF_C, (size_t)M_TOK * 1024, 0);
  GSYNC();
  for (int lv = 0; lv < DEPTH; ++lv) {
    int l = lv; asm volatile("" : "+s"(l));
    phase_gemm_in(p, l, lds);
    STOP(3, p.ws + A_PROJ, (size_t)M_TOK * IN_COLS, 0);
    GSYNC();
    phase_mid(p, l, lds);
    STOP(4, p.ws + A_QAN, (A_END - A_QAN) / 2, 0);
    GSYNC();
    phase_gemm_mix(p, l, lds);
    STOP(5, p.ws + B_Q, (B_END - B_Q) / 2, 0);
    GSYNC();
    phase_attn(p, lds);
    STOP(6, p.ws + OFF_C, (size_t)M_TOK * 1024, 0);
    GSYNC();
    phase_gemm_f32out(p, OFF_C, 1024, OFF_W + (size_t)l * WL_SIZE + WL_OUT, lds);
    STOP(7, p.ws + OFF_B, (size_t)M_TOK * 1024, 1);
    GSYNC();
    phase_rows(p, 1, l);
    STOP(8, p.ws + OFF_C, (size_t)M_TOK * 1024, 0);
    GSYNC();
    phase_gemm_up(p, l, lds);
    STOP(9, p.ws + OFF_A, (size_t)M_TOK * DFF, 0);
    GSYNC();
    phase_fixup(p, l);
    STOP(10, p.ws + OFF_A, (size_t)M_TOK * DFF, 0);
    GSYNC();
    phase_gemm_f32out(p, OFF_A, DFF, OFF_W + (size_t)l * WL_SIZE + WL_DOWN, lds);
    STOP(11, p.ws + OFF_B, (size_t)M_TOK * 1024, 1);
    GSYNC();
    phase_rows(p, 2, l);
    if (l + 1 < DEPTH) GSYNC();
  }
}

extern "C" void kernel_launch(void* const* d_in, const int* in_sizes, int n_in, void* d_out, int out_size, void* d_ws, size_t ws_size,
                              hipStream_t stream) {
  static int grid_blocks = 0;
  if (!grid_blocks) {
    if (n_in != 27 || ws_size < WS_END) { fprintf(stderr, "kernel_launch: bad n_in %d or ws_size %zu < %zu\n", n_in, ws_size, (size_t)WS_END); return; }
    if (hipFuncSetAttribute((const void*)fwd_megakernel, hipFuncAttributeMaxDynamicSharedMemorySize, LDS_BYTES) != hipSuccess) {
      fprintf(stderr, "kernel_launch: hipFuncSetAttribute failed\n"); return; }
    int dev = 0, cus = 0, per_cu = 0;
    hipGetDevice(&dev);
    hipDeviceGetAttribute(&cus, hipDeviceAttributeMultiprocessorCount, dev);
    hipOccupancyMaxActiveBlocksPerMultiprocessor(&per_cu, fwd_megakernel, NTHR, LDS_BYTES);
    if (per_cu < 1) { fprintf(stderr, "kernel_launch: occupancy 0\n"); return; }
    grid_blocks = cus;
  }
  Params p{};
  const float** pp = (const float**)&p;
  for (int i = 0; i < 27; ++i) pp[i] = (const float*)d_in[i];
  p.out = (float*)d_out;
  p.ws = (char*)d_ws;
  hipMemsetAsync((char*)d_ws + OFF_BAR, 0, XCD_BAR_WORDS * 4, stream);
  void* args[] = {&p};
  hipError_t e = hipLaunchCooperativeKernel((void*)fwd_megakernel, dim3(grid_blocks), dim3(NTHR), args, LDS_BYTES, stream);
  if (e != hipSuccess) fprintf(stderr, "cooperative launch failed: %s (grid %d)\n", hipGetErrorString(e), grid_blocks);
}
```
